# Optimizing an MI355X kernel written in HIP

```python
import math
import jax, jax.numpy as jnp
from jax import lax
import numpy as np

D_MODEL = 1024
BATCH = 8
SEQ = 2048
DEPTH = 1
DEC_BATCH = 128
DEC_SEQ = 8
PAST_LEN = 16384
PAGE_SIZE = 128

D_MIX = 2 * D_MODEL
HG_WIDTH = D_MIX // 2
HG_DK = 128
HG_DV = 128
HG_HEADS = HG_WIDTH // HG_DV
HG_CHUNK = 16
M_WIDTH = D_MIX - HG_WIDTH
M_HEADDIM = 64
M_HEADS = M_WIDTH // M_HEADDIM
M_DSTATE = 128
M_GROUPS = 2
M_CONV = 4
M_CHUNK = 128
M_CONV_DIM = M_WIDTH + 2 * M_GROUPS * M_DSTATE
D_FF = 4 * D_MODEL
NORM_EPS = 1e-5
SPLITS = (HG_HEADS * HG_DK, HG_HEADS * HG_DK, HG_WIDTH, HG_WIDTH, M_WIDTH, M_CONV_DIM, M_HEADS)
D_IN_PROJ = sum(SPLITS)
SPLIT_POINTS = tuple(sum(SPLITS[:i + 1]) for i in range(len(SPLITS) - 1))

kernel_name = 'hymba_hgrn2_ssd_decoder_step'


def rmsnorm(x, gain):
    xf = x.astype(jnp.float32)
    xf = xf * lax.rsqrt(jnp.mean(xf * xf, axis=-1, keepdims=True) + NORM_EPS)
    return (xf * gain.astype(jnp.float32)).astype(x.dtype)


def chunk_len(L, target):
    return L if L <= target else math.gcd(L, target)


def hgrn2_recurrence(q, k, v, log_f, s0):
    bsz, L, H, K = q.shape
    C = chunk_len(L, HG_CHUNK)
    n = L // C

    def blk(t):
        return t.reshape(bsz, n, C, H, t.shape[-1]).transpose(1, 0, 2, 3, 4)

    q, k, v, a = blk(q), blk(k), blk(v), blk(log_f)
    cum = jnp.cumsum(a, axis=2)
    cum_last = cum[:, :, -1:]
    qd = q * jnp.exp(cum)
    kd = k * jnp.exp(-cum)
    k_end = k * jnp.exp(cum_last - cum)
    chunk_decay = jnp.exp(cum_last[:, :, 0])
    causal = jnp.tril(jnp.ones((C, C), bool))
    att = jnp.einsum('cbthk,cbshk->cbhts', qd, kd)
    att = jnp.where(causal, att, 0.0)
    o_intra = jnp.einsum('cbhts,cbshv->cbthv', att, v)

    def step(s, inp):
        qd_c, ke_c, v_c, dec_c = inp
        o = jnp.einsum('bthk,bhkv->bthv', qd_c, s)
        s = dec_c[..., None] * s + jnp.einsum('bshk,bshv->bhkv', ke_c, v_c)
        return s, o

    s_fin, o_inter = lax.scan(step, s0, (qd, k_end, v, chunk_decay))
    o = (o_intra + o_inter).transpose(1, 0, 2, 3, 4).reshape(bsz, L, H, v.shape[-1])
    return o, s_fin


def ssd_scan(xs, dt, a, bm, cm, s0):
    bsz, L, H, P = xs.shape
    G, N = bm.shape[2], bm.shape[3]
    R = H // G
    C = chunk_len(L, M_CHUNK)
    n = L // C
    log_a = (dt * a).reshape(bsz, n, C, G, R).transpose(1, 0, 2, 3, 4)
    xdt = (xs * dt[..., None]).reshape(bsz, n, C, G, R, P).transpose(1, 0, 2, 3, 4, 5)
    bm = bm.reshape(bsz, n, C, G, N).transpose(1, 0, 2, 3, 4)
    cm = cm.reshape(bsz, n, C, G, N).transpose(1, 0, 2, 3, 4)
    cum = jnp.cumsum(log_a, axis=2)
    seg = cum[:, :, :, None] - cum[:, :, None, :]
    causal = jnp.tril(jnp.ones((C, C), bool))[:, :, None, None]
    decay = jnp.exp(jnp.where(causal, seg, -jnp.inf))
    cb = jnp.einsum('cbtgn,cbsgn->cbtsg', cm, bm)
    y_intra = jnp.einsum('cbtsg,cbtsgr,cbsgrp->cbtgrp', cb, decay, xdt)
    cum_last = cum[:, :, -1]
    to_end = jnp.exp(cum_last[:, :, None] - cum)
    from_start = jnp.exp(cum)
    chunk_decay = jnp.exp(cum_last)

    def step(s, inp):
        c_c, b_c, xdt_c, fs_c, te_c, cd_c = inp
        y = jnp.einsum('btgn,bgrpn->btgrp', c_c, s) * fs_c[..., None]
        s = cd_c[..., None, None] * s + jnp.einsum('bsgn,bsgr,bsgrp->bgrpn', b_c, te_c, xdt_c)
        return s, y

    s_fin, y_inter = lax.scan(step, s0.reshape(bsz, G, R, P, N),
                              (cm, bm, xdt, from_start, to_end, chunk_decay))
    y = (y_intra + y_inter).transpose(1, 0, 2, 3, 4, 5).reshape(bsz, L, H, P)
    return y, s_fin.reshape(bsz, H, P, N)


def decoder_layer(x, hg_s0, ssm_s0, conv0, lb, ln1, w_in, hg_norm, conv_w, conv_b,
                  dt_bias, a_log, d_skip, m_norm, w_out, ln2, w_up, w_down):
    f32 = jnp.float32
    bsz, L, _ = x.shape
    h = rmsnorm(x, ln1)
    proj = jnp.einsum('bld,de->ble', h, w_in)
    q, f_raw, i_in, g, z, xbc, dt_raw = jnp.split(proj, SPLIT_POINTS, axis=-1)

    f = lb + (1.0 - lb) * jax.nn.sigmoid(f_raw.astype(f32))
    log_f = jnp.log(f)
    k = 1.0 - f
    o_hg, hg_s = hgrn2_recurrence(
        q.astype(f32).reshape(bsz, L, HG_HEADS, HG_DK),
        k.reshape(bsz, L, HG_HEADS, HG_DK),
        i_in.astype(f32).reshape(bsz, L, HG_HEADS, HG_DV),
        log_f.reshape(bsz, L, HG_HEADS, HG_DK),
        hg_s0.astype(f32))
    o_hg = rmsnorm(o_hg, hg_norm).reshape(bsz, L, HG_WIDTH) * jax.nn.silu(g.astype(f32))

    xbc_full = jnp.concatenate([conv0.astype(xbc.dtype), xbc], axis=1)
    conv_new = xbc_full[:, L:]
    acc = conv_b.astype(f32)
    for j in range(M_CONV):
        acc = acc + xbc_full[:, j:j + L].astype(f32) * conv_w[j].astype(f32)
    xbc_act = jax.nn.silu(acc)
    xs, bm, cm = jnp.split(xbc_act, [M_WIDTH, M_WIDTH + M_GROUPS * M_DSTATE], axis=-1)
    xs = xs.reshape(bsz, L, M_HEADS, M_HEADDIM)
    bm = bm.reshape(bsz, L, M_GROUPS, M_DSTATE)
    cm = cm.reshape(bsz, L, M_GROUPS, M_DSTATE)
    dt = jax.nn.softplus(dt_raw.astype(f32) + dt_bias.astype(f32))
    a = -jnp.exp(a_log.astype(f32))
    y, ssm_s = ssd_scan(xs, dt, a, bm, cm, ssm_s0.astype(f32))
    y = y + d_skip.astype(f32)[:, None] * xs
    y = y.reshape(bsz, L, M_WIDTH) * jax.nn.silu(z.astype(f32))
    y = rmsnorm(y.reshape(bsz, L, M_GROUPS, M_WIDTH // M_GROUPS),
                m_norm.reshape(M_GROUPS, M_WIDTH // M_GROUPS)).reshape(bsz, L, M_WIDTH)

    mix = jnp.concatenate([o_hg, y], axis=-1).astype(x.dtype)
    x = x + jnp.einsum('ble,ed->bld', mix, w_out)

    u = jax.nn.relu(jnp.einsum('bld,df->blf', rmsnorm(x, ln2), w_up))
    x = x + jnp.einsum('blf,fd->bld', u * u, w_down)
    return x, hg_s.astype(x.dtype), ssm_s.astype(x.dtype), conv_new


def setup_inputs(seed: int = 0) -> dict:
    key = jax.random.key(seed)
    ks = jax.random.split(key, 24)
    nrm = jax.random.normal
    dt0 = jnp.exp(jax.random.uniform(ks[10], (DEPTH, M_HEADS), minval=math.log(1e-3), maxval=math.log(1e-1)))
    return {
        'x_prompt': nrm(ks[0], (BATCH, SEQ, D_MODEL), jnp.float32),
        'x_sample': nrm(ks[1], (DEC_BATCH, DEC_SEQ, D_MODEL), jnp.float32),
        'state_hgrn': 0.5 * nrm(ks[2], (DEPTH, DEC_BATCH, HG_HEADS, HG_DK, HG_DV), jnp.float32),
        'state_ssm': 0.3 * nrm(ks[3], (DEPTH, DEC_BATCH, M_HEADS, M_HEADDIM, M_DSTATE), jnp.float32),
        'state_conv': nrm(ks[4], (DEPTH, DEC_BATCH, M_CONV - 1, M_CONV_DIM), jnp.float32),
        'hg_lb_logits': 0.1 * nrm(ks[5], (DEPTH + 1, HG_HEADS * HG_DK), jnp.float32),
        'ln1': 1.0 + 0.02 * nrm(ks[6], (DEPTH, D_MODEL), jnp.float32),
        'w_in': nrm(ks[7], (DEPTH, D_MODEL, D_IN_PROJ), jnp.float32) * D_MODEL ** -0.5,
        'hg_norm': 1.0 + 0.02 * nrm(ks[8], (DEPTH, HG_HEADS, HG_DV), jnp.float32),
        'conv_w': nrm(ks[9], (DEPTH, M_CONV, M_CONV_DIM), jnp.float32) * M_CONV ** -0.5,
        'conv_b': 0.02 * nrm(ks[11], (DEPTH, M_CONV_DIM), jnp.float32),
        'dt_bias': dt0 + jnp.log(-jnp.expm1(-dt0)),
        'a_log': jnp.log(jax.random.uniform(ks[12], (DEPTH, M_HEADS), minval=1.0, maxval=16.0)),
        'd_skip': 1.0 + 0.1 * nrm(ks[13], (DEPTH, M_HEADS), jnp.float32),
        'm_norm': 1.0 + 0.02 * nrm(ks[14], (DEPTH, M_WIDTH), jnp.float32),
        'w_out': nrm(ks[15], (DEPTH, D_MIX, D_MODEL), jnp.float32) * D_MIX ** -0.5,
        'ln2': 1.0 + 0.02 * nrm(ks[16], (DEPTH, D_MODEL), jnp.float32),
        'w_up': nrm(ks[17], (DEPTH, D_MODEL, D_FF), jnp.float32) * D_MODEL ** -0.5,
        'w_down': nrm(ks[18], (DEPTH, D_FF, D_MODEL), jnp.float32) * D_FF ** -0.5,
        'ln_f': 1.0 + 0.02 * nrm(ks[19], (D_MODEL,), jnp.float32),
    }


def reference(x_prompt, x_sample, state_hgrn, state_ssm, state_conv, hg_lb_logits, ln1, w_in,
              hg_norm, conv_w, conv_b, dt_bias, a_log, d_skip, m_norm, w_out, ln2, w_up, w_down, ln_f):
    lb_all = jnp.cumsum(jax.nn.softmax(hg_lb_logits.astype(jnp.float32), axis=0), axis=0)
    yp, ys = x_prompt, x_sample
    bp = x_prompt.shape[0]
    hgp, hgs, ssp, sss, cvp, cvs = [], [], [], [], [], []
    for l in range(DEPTH):
        w = (ln1[l], w_in[l], hg_norm[l], conv_w[l], conv_b[l], dt_bias[l], a_log[l],
             d_skip[l], m_norm[l], w_out[l], ln2[l], w_up[l], w_down[l])
        hg0 = jnp.zeros((bp, HG_HEADS, HG_DK, HG_DV), yp.dtype)
        ssm0 = jnp.zeros((bp, M_HEADS, M_HEADDIM, M_DSTATE), yp.dtype)
        conv0 = jnp.zeros((bp, M_CONV - 1, M_CONV_DIM), yp.dtype)
        yp, h_p, s_p, c_p = decoder_layer(yp, hg0, ssm0, conv0, lb_all[l], *w)
        ys, h_s, s_s, c_s = decoder_layer(ys, state_hgrn[l], state_ssm[l], state_conv[l], lb_all[l], *w)
        hgp.append(h_p); hgs.append(h_s)
        ssp.append(s_p); sss.append(s_s)
        cvp.append(c_p); cvs.append(c_s)
    y_prompt = rmsnorm(yp, ln_f)
    y_sample = rmsnorm(ys, ln_f)
    return (y_prompt, y_sample, jnp.stack(hgp), jnp.stack(hgs), jnp.stack(ssp), jnp.stack(sss),
            jnp.stack(cvp), jnp.stack(cvs))
```

```cpp
#define ENG_H 1
#define ENG_S 1
#include <hip/hip_runtime.h>
#include <cstdio>
#include <cstdint>
namespace pg8 {
#define PG8_LAS __attribute__((address_space(3)))
typedef unsigned short bf16_t;
typedef short bf16x8 __attribute__((ext_vector_type(8)));
typedef float f32x4 __attribute__((ext_vector_type(4)));
typedef unsigned u32x4 __attribute__((ext_vector_type(4)));
constexpr int BM = 256, BK = 64, HALF = 128, HTB = HALF * BK * 2  , STAGE_BYTES = 8 * HTB, NXCD = 8, WGM = 8;

__host__ __device__ __forceinline__ int lds_byte(int r, int c) { const int st = (r >> 4) * 2 + (c >> 5), rr = r & 15, cc = c & 31, ob = rr * 64 + cc * 2; return st * 1024 + (ob ^ (((ob >> 9) & 1) << 5)); }
__host__ __device__ __forceinline__ void stage_rc(int b, int& R, int& C) { const int st = b / 1024, sb = b % 1024, swz = sb ^ (((sb >> 9) & 1) << 5); R = (st >> 1) * 16 + swz / 64; C = (st & 1) * 32 + (swz % 64) / 2; }
__host__ __device__ __forceinline__ int perm32(int rho) { const int n = rho >> 4, i = rho & 15; return 8 * (i >> 2) + 4 * n + (i & 3); }

struct Unit { int pm, pn, ks; };
struct Gemm { const bf16_t* A; const bf16_t* Bt; int M, N, K, ld; };

struct StaticOrder {
    int nM, nN, nwg, G, c;
    __host__ __device__ void init(int M, int N, int G_, int c_) { nM = M / BM; nN = N / BM; nwg = nM * nN; G = G_; c = c_; }
    __host__ __device__ bool next(int i, Unit& u) const {
        const long L = (long)i * G + c; if (L >= nwg) return false;
        int wgid = (int)L; { const int q = nwg / NXCD, r = nwg % NXCD, xcd = wgid % NXCD, off = wgid / NXCD; wgid = (xcd < r ? xcd * (q + 1) : r * (q + 1) + (xcd - r) * q) + off; }
        const int nig = WGM * nN, gid = wgid / nig, fm = gid * WGM, gsz = (nM - fm) < WGM ? (nM - fm) : WGM;
        u.pm = fm + ((wgid % nig) % gsz); u.pn = (wgid % nig) / gsz; u.ks = 0; return true;
    }
    __device__ __forceinline__ void a_ready(const Unit&) const {}
    __device__ __forceinline__ void done(const Unit&) const {}
};

__device__ __forceinline__ unsigned cvt_pk_bf16(float lo, float hi) { unsigned r; asm volatile("v_cvt_pk_bf16_f32 %0, %1, %2" : "=v"(r) : "v"(lo), "v"(hi)); return r; }
__device__ __forceinline__ unsigned pk_f16(float lo, float hi) { _Float16 a = (_Float16)lo, b = (_Float16)hi; return (unsigned)__builtin_bit_cast(unsigned short, a) | ((unsigned)__builtin_bit_cast(unsigned short, b) << 16); }
__device__ __forceinline__ float silu_f(float x) { return x * __builtin_amdgcn_rcpf(1.0f + __expf(-x)); }
typedef unsigned u32x2 __attribute__((ext_vector_type(2)));
constexpr int MP_ROWS = 16384;

struct EpiIn {
    static constexpr bool PERM = true, AFTER_DRAIN = false;
    bf16_t* QZ; bf16_t* F; bf16_t* I; bf16_t* G; bf16_t* XBC; const float* LB; float* cvp; float* cvs;
    __device__ __forceinline__ void operator()(const f32x4 (&acc)[2][2][4][2], const Unit& u, int wr, int wc, int fr, int fq) const {
        const int pn = u.pn, row0 = u.pm * BM + wr * 64 + fr, cl = wc * 32 + 8 * fq;
        int reg, ldc, colt; bf16_t* base;
        if (pn < 4)       { base = QZ;        ldc = 2048; colt = pn * 256;        reg = 0; }
        else if (pn < 8)  { base = F;         ldc = 1024; colt = (pn - 4) * 256;  reg = 1; }
        else if (pn < 12) { base = I;         ldc = 1024; colt = (pn - 8) * 256;  reg = 0; }
        else if (pn < 16) { base = G;         ldc = 1024; colt = (pn - 12) * 256; reg = 2; }
        else if (pn < 20) { base = QZ + 1024; ldc = 2048; colt = (pn - 16) * 256; reg = 2; }
        else              { base = XBC;       ldc = 1536; colt = (pn - 20) * 256; reg = 3; }
        f32x4 lb[2][2];
        if (reg == 1) {
#pragma unroll
            for (int bj = 0; bj < 2; ++bj)
#pragma unroll
                for (int n = 0; n < 2; ++n) lb[bj][n] = *(const f32x4*)(LB + colt + cl + bj * HALF + 4 * n);
        }
#pragma unroll
        for (int ai = 0; ai < 2; ++ai)
#pragma unroll
            for (int m = 0; m < 4; ++m) {
                const int row = row0 + ai * HALF + m * 16;
                bf16_t* rowp = base + (size_t)row * ldc + colt + cl;
                float* cdst = nullptr;
                if (reg == 3) {
                    if (row < MP_ROWS) { const int t = row & 2047; if (t >= 2045) cdst = cvp + (size_t)((row >> 11) * 3 + (t - 2045)) * 1536 + colt + cl; }
                    else { const int r = row - MP_ROWS, t = r & 7; if (t >= 5) cdst = cvs + (size_t)((r >> 3) * 3 + (t - 5)) * 1536 + colt + cl; }
                }
#pragma unroll
                for (int bj = 0; bj < 2; ++bj) {
                    f32x4 v0 = acc[ai][bj][m][0], v1 = acc[ai][bj][m][1];
                    u32x4 w;
                    if (reg == 1) {
                        f32x4 l0 = lb[bj][0], l1 = lb[bj][1];
#pragma unroll
                        for (int e = 0; e < 4; ++e) {
                            float s0 = __builtin_amdgcn_rcpf(1.0f + __expf(-v0[e])), s1 = __builtin_amdgcn_rcpf(1.0f + __expf(-v1[e]));
                            v0[e] = __logf(l0[e] + (1.0f - l0[e]) * s0); v1[e] = __logf(l1[e] + (1.0f - l1[e]) * s1);
                        }
                        w.x = pk_f16(v0[0], v0[1]); w.y = pk_f16(v0[2], v0[3]); w.z = pk_f16(v1[0], v1[1]); w.w = pk_f16(v1[2], v1[3]);
                    } else {
                        if (reg == 2) {
#pragma unroll
                            for (int e = 0; e < 4; ++e) { v0[e] = silu_f(v0[e]); v1[e] = silu_f(v1[e]); }
                        }
                        if (reg == 3 && cdst) { *(f32x4*)(cdst + bj * HALF) = v0; *(f32x4*)(cdst + bj * HALF + 4) = v1; }
                        w.x = cvt_pk_bf16(v0[0], v0[1]); w.y = cvt_pk_bf16(v0[2], v0[3]); w.z = cvt_pk_bf16(v1[0], v1[1]); w.w = cvt_pk_bf16(v1[2], v1[3]);
                    }
                    *(u32x4*)(rowp + bj * HALF) = w;
                }
            }
    }
};

struct EpiOut {
    static constexpr bool PERM = false, AFTER_DRAIN = false;
    const float* xp; const float* xs; float* X1; bf16_t* XG; const float* ln2; float* rowss;
    __device__ __forceinline__ void operator()(const f32x4 (&acc)[2][2][4][2], const Unit& u, int wr, int wc, int fr, int fq) const {
        const int row0 = u.pm * BM + wr * 64 + fr, col0 = u.pn * BM + wc * 32 + 4 * fq;
        f32x4 gn[2][2];
#pragma unroll
        for (int bj = 0; bj < 2; ++bj)
#pragma unroll
            for (int n = 0; n < 2; ++n) gn[bj][n] = *(const f32x4*)(ln2 + col0 + bj * HALF + n * 16);
#pragma unroll
        for (int ai = 0; ai < 2; ++ai)
#pragma unroll
            for (int m = 0; m < 4; ++m) {
                const int row = row0 + ai * HALF + m * 16;
                const float* xin = (row < MP_ROWS) ? xp + (size_t)row * 1024 : xs + (size_t)(row - MP_ROWS) * 1024;
                float ss = 0.f;
#pragma unroll
                for (int bj = 0; bj < 2; ++bj)
#pragma unroll
                    for (int n = 0; n < 2; ++n) {
                        const int col = col0 + bj * HALF + n * 16;
                        const f32x4 v = *(const f32x4*)(xin + col) + acc[ai][bj][m][n];
                        *(f32x4*)(X1 + (size_t)row * 1024 + col) = v;
                        ss += (v[0] * v[0] + v[1] * v[1]) + (v[2] * v[2] + v[3] * v[3]);
                        const f32x4 g = v * gn[bj][n]; u32x2 w; w.x = cvt_pk_bf16(g[0], g[1]); w.y = cvt_pk_bf16(g[2], g[3]);
                        *(u32x2*)(XG + (size_t)row * 1024 + col) = w;
                    }
                ss += __shfl_xor(ss, 16); ss += __shfl_xor(ss, 32);
                if (fq == 0) unsafeAtomicAdd(rowss + row, ss);
            }
    }
};

struct EpiUp {
    static constexpr bool PERM = true, AFTER_DRAIN = false;
    bf16_t* U; const float* rowss;
    __device__ __forceinline__ void operator()(const f32x4 (&acc)[2][2][4][2], const Unit& u, int wr, int wc, int fr, int fq) const {
        const int row0 = u.pm * BM + wr * 64 + fr, col0 = u.pn * BM + wc * 32 + 8 * fq;
#pragma unroll
        for (int ai = 0; ai < 2; ++ai)
#pragma unroll
            for (int m = 0; m < 4; ++m) {
                const int row = row0 + ai * HALF + m * 16;
                const float rs = __builtin_amdgcn_rsqf(rowss[row] * (1.0f / 1024.0f) + 1e-5f);
                bf16_t* rowp = U + (size_t)row * 4096 + col0;
#pragma unroll
                for (int bj = 0; bj < 2; ++bj) {
                    f32x4 v0 = acc[ai][bj][m][0] * rs, v1 = acc[ai][bj][m][1] * rs;
#pragma unroll
                    for (int e = 0; e < 4; ++e) { float a = fmaxf(v0[e], 0.f), b = fmaxf(v1[e], 0.f); v0[e] = a * a; v1[e] = b * b; }
                    u32x4 w; w.x = cvt_pk_bf16(v0[0], v0[1]); w.y = cvt_pk_bf16(v0[2], v0[3]); w.z = cvt_pk_bf16(v1[0], v1[1]); w.w = cvt_pk_bf16(v1[2], v1[3]);
                    *(u32x4*)(rowp + bj * HALF) = w;
                }
            }
    }
};

struct EpiDown {
    static constexpr bool PERM = false, AFTER_DRAIN = false;
    float* X1;
    __device__ __forceinline__ void operator()(const f32x4 (&acc)[2][2][4][2], const Unit& u, int wr, int wc, int fr, int fq) const {
        const int row0 = u.pm * BM + wr * 64 + fr, col0 = u.pn * BM + wc * 32 + 4 * fq;
#pragma unroll
        for (int ai = 0; ai < 2; ++ai)
#pragma unroll
            for (int m = 0; m < 4; ++m) {
                const int row = row0 + ai * HALF + m * 16;
#pragma unroll
                for (int bj = 0; bj < 2; ++bj)
#pragma unroll
                    for (int n = 0; n < 2; ++n) { float* p = X1 + (size_t)row * 1024 + col0 + bj * HALF + n * 16; *(f32x4*)p = *(const f32x4*)p + acc[ai][bj][m][n]; }
            }
    }
};
struct EpiDownSplit {
    static constexpr bool PERM = false, AFTER_DRAIN = false;
    float* PART;
    __device__ __forceinline__ void operator()(const f32x4 (&acc)[2][2][4][2], const Unit& u, int wr, int wc, int fr, int fq) const {
        const int row0 = (u.pm - 64) * BM + wr * 64 + fr, col0 = u.pn * BM + wc * 32 + 4 * fq;
        float* base = PART + (size_t)u.ks * 1024 * 1024;
#pragma unroll
        for (int ai = 0; ai < 2; ++ai)
#pragma unroll
            for (int m = 0; m < 4; ++m) {
                const int row = row0 + ai * HALF + m * 16;
#pragma unroll
                for (int bj = 0; bj < 2; ++bj)
#pragma unroll
                    for (int n = 0; n < 2; ++n) *(f32x4*)(base + (size_t)row * 1024 + col0 + bj * HALF + n * 16) = acc[ai][bj][m][n];
            }
    }
};
struct SplitOrder {
    int G, c;
    __device__ bool next(int i, Unit& u) const { const int t = i * G + c; if (t >= 128) return false; const int tile = t >> 3; u.pm = 64 + (tile >> 2); u.pn = tile & 3; u.ks = t & 7; return true; }
    __device__ __forceinline__ void a_ready(const Unit&) const {}
    __device__ __forceinline__ void done(const Unit&) const {}
};

template <class Epi, class Sched, bool ALIGN_EPI = false, bool SP2 = false>
__device__ __forceinline__ void gemm_phase(PG8_LAS unsigned char* lds, const Gemm g, const Sched& S, const Epi& E) {
    int tid_ = threadIdx.x; asm volatile("" : "+v"(tid_));
    const int tid = tid_, wid = __builtin_amdgcn_readfirstlane(tid >> 6), lane = tid & 63, wr = wid >> 2, wc = wid & 3, fr = lane & 15, fq = lane >> 4;
    const int K = g.ld, nt = g.K / BK;
    unsigned voffA[2], voffB[2];
#pragma unroll
    for (int i = 0; i < 2; ++i) { int R, C; stage_rc(tid * 16 + i * 8192, R, C); const int Rb = Epi::PERM ? ((R & ~31) + perm32(R & 31)) : R;
        voffA[i] = (unsigned)(R * K + C) * 2u; voffB[i] = (unsigned)(Rb * K + C) * 2u; }
    const size_t kstep = (size_t)(BK * 2);
    const size_t hstep = (size_t)HALF * K * 2;
    const size_t tstep = 2 * hstep;
    const unsigned ldsw = (unsigned)wid * 1024u;
    const int aoff = lds_byte(wr * 64 + fr, fq * 8), boff = lds_byte(wc * 32 + fr, fq * 8);
#define PG8_SA(b, h) (((b) * 2 + (h)) * HTB)
#define PG8_SB(b, h) ((4 + (b) * 2 + (h)) * HTB)
#define PG8_STAGE(bufoff, gbase, voff) do { _Pragma("unroll") for (int _i = 0; _i < 2; ++_i) \
        __builtin_amdgcn_global_load_lds((const unsigned*)((const char*)(gbase) + (voff)[_i]), (PG8_LAS unsigned*)(lds + (bufoff) + ldsw + _i * 8192), 16, 0, 0); } while (0)
#define PG8_LDA(dst, b, h) do { _Pragma("unroll") for (int m = 0; m < 4; ++m) _Pragma("unroll") for (int k = 0; k < 2; ++k) dst[m][k] = *(const PG8_LAS bf16x8*)(lds + PG8_SA(b, h) + aoff + m * 2048 + k * 1024); } while (0)
#define PG8_LDB(dst, b, h) do { _Pragma("unroll") for (int n = 0; n < 2; ++n) _Pragma("unroll") for (int k = 0; k < 2; ++k) dst[n][k] = *(const PG8_LAS bf16x8*)(lds + PG8_SB(b, h) + boff + n * 2048 + k * 1024); } while (0)
#define PG8_MMA(ai, bj, At, Bt) do { __builtin_amdgcn_s_setprio(1); _Pragma("unroll") for (int m = 0; m < 4; ++m) _Pragma("unroll") for (int n = 0; n < 2; ++n) _Pragma("unroll") for (int k = 0; k < 2; ++k) \
        acc[ai][bj][m][n] = __builtin_amdgcn_mfma_f32_16x16x32_bf16(Bt[n][k], At[m][k], acc[ai][bj][m][n], 0, 0, 0); __builtin_amdgcn_s_setprio(0); } while (0)
#define PG8_WAIT_V(n) asm volatile("s_waitcnt vmcnt(" #n ")" ::: "memory")
#define PG8_WAIT_L(n) asm volatile("s_waitcnt lgkmcnt(" #n ")" ::: "memory")
#define PG8_BAR __builtin_amdgcn_s_barrier()
#define PG8_SCHED __builtin_amdgcn_sched_barrier(0)
    Unit cur, nxt; int ui = 0;
    if (!S.next(0, cur)) return;
    f32x4 acc[2][2][4][2];
#pragma unroll
    for (int a = 0; a < 2; ++a)
#pragma unroll
        for (int b = 0; b < 2; ++b)
#pragma unroll
            for (int m = 0; m < 4; ++m)
#pragma unroll
                for (int n = 0; n < 2; ++n) acc[a][b][m][n] = (f32x4){0.f, 0.f, 0.f, 0.f};
    bf16x8 At[4][2], B0[2][2], B1[2][2];
    const size_t sstep = (size_t)g.K * 2;
    const char* cA = (const char*)g.A + (size_t)cur.pm * tstep + (size_t)cur.ks * sstep; const char* cB = (const char*)g.Bt + (size_t)cur.pn * tstep + (size_t)cur.ks * sstep;
    S.a_ready(cur);
    if constexpr (SP2) {
        PG8_STAGE(PG8_SB(0, 0), cB, voffB); PG8_STAGE(PG8_SB(0, 1), cB + hstep, voffB); PG8_STAGE(PG8_SA(0, 0), cA, voffA); PG8_STAGE(PG8_SA(0, 1), cA + hstep, voffA);
        if (wr == 1) PG8_BAR;
        PG8_WAIT_V(2); PG8_BAR;
        PG8_STAGE(PG8_SB(1, 0), cB + kstep, voffB); PG8_STAGE(PG8_SA(1, 0), cA + kstep, voffA); PG8_STAGE(PG8_SB(1, 1), cB + hstep + kstep, voffB);
        PG8_WAIT_V(6); PG8_BAR;
    } else {
        PG8_STAGE(PG8_SB(0, 0), cB, voffB); PG8_STAGE(PG8_SA(0, 0), cA, voffA); PG8_STAGE(PG8_SB(0, 1), cB + hstep, voffB); PG8_STAGE(PG8_SA(0, 1), cA + hstep, voffA);
        if (wr == 1) PG8_BAR;
        PG8_WAIT_V(4); PG8_BAR;
        PG8_STAGE(PG8_SB(1, 0), cB + kstep, voffB); PG8_STAGE(PG8_SA(1, 0), cA + kstep, voffA); PG8_STAGE(PG8_SB(1, 1), cB + hstep + kstep, voffB);
        PG8_WAIT_V(6); PG8_BAR;
    }
    for (;;) {
        const bool has_next = S.next(ui + 1, nxt);
        const char* nA = has_next ? (const char*)g.A + (size_t)nxt.pm * tstep + (size_t)nxt.ks * sstep : cA; const char* nB = has_next ? (const char*)g.Bt + (size_t)nxt.pn * tstep + (size_t)nxt.ks * sstep : cB;
        for (int t = 0; t < nt; t += 2) {
            const bool last = (t == nt - 2);
            const char* a1 = cA + (size_t)(t + 1) * kstep;
            const char* a2 = last ? nA : cA + (size_t)(t + 2) * kstep; const char* b2 = last ? nB : cB + (size_t)(t + 2) * kstep;
            const char* a3 = a2 + kstep; const char* b3 = b2 + kstep;
            if (last && has_next) S.a_ready(nxt);
            if constexpr (SP2) {
            PG8_LDB(B0, 0, 0); PG8_LDB(B1, 0, 1); PG8_SCHED; PG8_LDA(At, 0, 0); PG8_STAGE(PG8_SA(1, 1), a1 + hstep, voffA);
            PG8_WAIT_V(8); PG8_WAIT_L(0); PG8_BAR; PG8_MMA(0, 0, At, B0); PG8_MMA(0, 1, At, B1); PG8_BAR; PG8_SCHED;
            PG8_LDA(At, 0, 1); PG8_STAGE(PG8_SB(0, 0), b2, voffB); PG8_STAGE(PG8_SB(0, 1), b2 + hstep, voffB); PG8_STAGE(PG8_SA(0, 0), a2, voffA);
            PG8_WAIT_V(8); PG8_WAIT_L(0); PG8_BAR; PG8_MMA(1, 0, At, B0); PG8_MMA(1, 1, At, B1); PG8_BAR; PG8_SCHED;
            PG8_LDB(B0, 1, 0); PG8_LDB(B1, 1, 1); PG8_SCHED; PG8_LDA(At, 1, 0); PG8_STAGE(PG8_SA(0, 1), a2 + hstep, voffA);
            PG8_WAIT_V(8); PG8_WAIT_L(0); PG8_BAR; PG8_MMA(0, 0, At, B0); PG8_MMA(0, 1, At, B1); PG8_BAR; PG8_SCHED;
            PG8_LDA(At, 1, 1); PG8_STAGE(PG8_SB(1, 0), b3, voffB); PG8_STAGE(PG8_SB(1, 1), b3 + hstep, voffB); PG8_STAGE(PG8_SA(1, 0), a3, voffA);
            PG8_WAIT_V(8); PG8_WAIT_L(0); PG8_BAR; PG8_MMA(1, 0, At, B0); PG8_MMA(1, 1, At, B1); PG8_BAR; PG8_SCHED;
            } else {
            PG8_LDB(B0, 0, 0); PG8_SCHED; PG8_LDA(At, 0, 0); PG8_STAGE(PG8_SA(1, 1), a1 + hstep, voffA);
            PG8_WAIT_L(8); PG8_BAR; PG8_WAIT_L(0); PG8_MMA(0, 0, At, B0); PG8_BAR; PG8_SCHED;
            PG8_LDB(B1, 0, 1); PG8_STAGE(PG8_SB(0, 0), b2, voffB);
            PG8_BAR; PG8_WAIT_L(0); PG8_MMA(0, 1, At, B1); PG8_BAR;
            PG8_LDA(At, 0, 1); PG8_STAGE(PG8_SA(0, 0), a2, voffA);
            PG8_BAR; PG8_WAIT_L(0); PG8_MMA(1, 0, At, B0); PG8_BAR; PG8_SCHED;
            PG8_STAGE(PG8_SB(0, 1), b2 + hstep, voffB);
            PG8_WAIT_V(6); PG8_BAR; PG8_MMA(1, 1, At, B1); PG8_BAR;
            PG8_LDB(B0, 1, 0); PG8_SCHED; PG8_LDA(At, 1, 0); PG8_STAGE(PG8_SA(0, 1), a2 + hstep, voffA);
            PG8_WAIT_L(8); PG8_BAR; PG8_WAIT_L(0); PG8_MMA(0, 0, At, B0); PG8_BAR; PG8_SCHED;
            PG8_LDB(B1, 1, 1); PG8_STAGE(PG8_SB(1, 0), b3, voffB);
            PG8_BAR; PG8_WAIT_L(0); PG8_MMA(0, 1, At, B1); PG8_BAR;
            PG8_LDA(At, 1, 1); PG8_STAGE(PG8_SA(1, 0), a3, voffA);
            PG8_BAR; PG8_WAIT_L(0); PG8_MMA(1, 0, At, B0); PG8_BAR; PG8_SCHED;
            PG8_STAGE(PG8_SB(1, 1), b3 + hstep, voffB);
            PG8_WAIT_V(6); PG8_BAR; PG8_MMA(1, 1, At, B1); PG8_BAR;
            }
        }
        if constexpr (ALIGN_EPI) { if (wr == 0) PG8_BAR; }
        if constexpr (!Epi::AFTER_DRAIN) { E(acc, cur, wr, wc, fr, fq); S.done(cur); }
        if (!has_next) break;
#pragma unroll
        for (int a = 0; a < 2; ++a)
#pragma unroll
            for (int b = 0; b < 2; ++b)
#pragma unroll
                for (int m = 0; m < 4; ++m)
#pragma unroll
                    for (int n = 0; n < 2; ++n) acc[a][b][m][n] = (f32x4){0.f, 0.f, 0.f, 0.f};
        cur = nxt; cA = nA; cB = nB; ++ui;
        if constexpr (ALIGN_EPI) { if (wr == 1) PG8_BAR; }
    }
    PG8_WAIT_V(0);
    if constexpr (!ALIGN_EPI) { if (wr == 0) PG8_BAR; }
    PG8_BAR;
    if constexpr (Epi::AFTER_DRAIN) { E.fused(acc, cur, wr, wc, fr, fq, lds, wid, lane); S.done(cur); }
#undef PG8_SA
#undef PG8_SB
#undef PG8_STAGE
#undef PG8_LDA
#undef PG8_LDB
#undef PG8_MMA
#undef PG8_WAIT_V
#undef PG8_WAIT_L
#undef PG8_BAR
#undef PG8_SCHED
}
}
#include <hip/hip_cooperative_groups.h>
namespace cg = cooperative_groups;
#define LAS __attribute__((address_space(3)))
typedef unsigned short bf16;
typedef pg8::f32x4 f32x4;
typedef pg8::u32x4 u32x4;
typedef pg8::u32x2 u32x2;
typedef float f32x2 __attribute__((ext_vector_type(2)));
typedef pg8::bf16x8 bf16x8;
using pg8::cvt_pk_bf16;
using pg8::silu_f;
constexpr int NWAVES = 8;
constexpr int M = 17408, MP = 16384, MS = 1024, D = 1024, NIN = 6656, LDWIN = 6672, DMIX = 2048, FF = 4096;
constexpr float EPS = 1e-5f;
constexpr size_t MiB = 1u << 20;
constexpr size_t WS_PART = 232 * MiB;
constexpr size_t WS_HD = 1572864, WS_SD = 1835008, WS_SSQ = 1884160;
constexpr size_t WS_DT = 0, WS_RSS1 = 1114112, WS_RSS2 = WS_RSS1 + 69632, WS_LB = WS_RSS2 + 69632;
constexpr size_t WS_WIN = 2 * MiB, WS_WOUT = 15 * MiB, WS_WUP = 19 * MiB, WS_WDN = 27 * MiB, WS_F = 35 * MiB, WS_XG = 35 * MiB, WS_QZ = 69 * MiB, WS_XBC = 137 * MiB;
constexpr size_t WS_HSEG = 188 * MiB, WS_SSEG = 204 * MiB, WS_XN = 188 * MiB, WS_U = 69 * MiB, WS_XBA = 188 * MiB, WS_END = 264 * MiB;
constexpr size_t O_Y = 0, O_HGP = 17825792, O_HGS = 18874368, O_SSP = 35651584, O_SSS = 36700160, O_CVP = 53477376, O_CVS = 53514240, O_END = 54104064;
constexpr int LDS_BYTES = 147456;

__device__ __forceinline__ float wave_sum(float v) {
#pragma unroll
    for (int o = 1; o < 64; o <<= 1) v += __shfl_xor(v, o);
    return v;
}
__device__ __forceinline__ float bf2f(bf16 b) { return __uint_as_float((unsigned)b << 16); }
__device__ __forceinline__ float h2f(unsigned short h) { return (float)__builtin_bit_cast(_Float16, h); }

#define XB_TMO      128
#define XB_XCNT(j)  (256  + 64 * (j))
#define XB_XSUB(j)  (1280 + 64 * (j))
#define XB_XGEN(j)  (2304 + 64 * (j))
#define XB_TOP      3328
#define XB_TOPGEN   3392
#define XCD_BAR_WORDS 3456
#define XB_SPIN_CAP (1u << 18)

__device__ __forceinline__ unsigned xb_ld(unsigned* p)              { return __hip_atomic_load(p, __ATOMIC_RELAXED, __HIP_MEMORY_SCOPE_AGENT); }
__device__ __forceinline__ unsigned xb_add(unsigned* p, unsigned v) { return __hip_atomic_fetch_add(p, v, __ATOMIC_RELAXED, __HIP_MEMORY_SCOPE_AGENT); }
__device__ __forceinline__ unsigned xb_xcc_id() { return (unsigned)__builtin_amdgcn_s_getreg((3 << 11) | 20) & 0xFu; }
#define XB_SPIN(cond, bar) do { unsigned _sp = 0; while (cond) { __builtin_amdgcn_s_sleep(1); \
    if ((++_sp & 255u) == 0u) { if (xb_ld(&(bar)[XB_TMO])) break; if (_sp > XB_SPIN_CAP) { atomicAdd(&(bar)[XB_TMO], 1u); break; } } } } while (0)

struct XcdBarrier {
    unsigned* bar; unsigned x;
    volatile LAS unsigned* st;
};

__device__ __forceinline__ XcdBarrier xcd_barrier_post(unsigned* bar, volatile LAS unsigned* st) {
    XcdBarrier b; b.bar = bar; b.x = xb_xcc_id(); b.st = st;
    if (threadIdx.x == 0) (void)xb_add(&bar[XB_XCNT(b.x)], 1u);
    return b;
}
__device__ __forceinline__ void xcd_barrier_complete(unsigned* bar, unsigned x, unsigned& nloc, unsigned& nx) {
    const unsigned G = gridDim.x * gridDim.y * gridDim.z;
    unsigned sum, cnt, mine, sp = 0u;
    for (;;) {
        sum = 0u; cnt = 0u; mine = 0u;
#pragma unroll
        for (unsigned j = 0; j < 16; ++j) { const unsigned c = xb_ld(&bar[XB_XCNT(j)]); sum += c; cnt += (c > 0u) ? 1u : 0u; mine = (j == x) ? c : mine; }
        if (sum == G) break;
        __builtin_amdgcn_s_sleep(1);
        if ((++sp & 255u) == 0u) { if (xb_ld(&bar[XB_TMO])) break; if (sp > XB_SPIN_CAP) { atomicAdd(&bar[XB_TMO], 1u); break; } }
    }
    nloc = mine > 0u ? mine : 1u; nx = cnt > 0u ? cnt : 1u;
}

__device__ __forceinline__ void xcd_barrier(const XcdBarrier& b) {
    asm volatile("s_waitcnt vmcnt(0)" ::: "memory");
    __syncthreads();
    if (threadIdx.x == 0) {
        unsigned* bar = b.bar;
        __builtin_amdgcn_s_waitcnt(0);
        unsigned nloc = b.st[0], nx = b.st[1];
        if (nloc == 0u) { xcd_barrier_complete(bar, b.x, nloc, nx); b.st[0] = nloc; b.st[1] = nx; }
        const unsigned old = xb_add(&bar[XB_XSUB(b.x)], 1u);
        const unsigned gen = old / nloc;
        if (old + 1u == (gen + 1u) * nloc) {
            __builtin_amdgcn_fence(__ATOMIC_RELEASE, "agent");
            asm volatile("s_waitcnt vmcnt(0)" ::: "memory");
            const unsigned og = xb_add(&bar[XB_TOP], 1u);
            const unsigned tg = og / nx;
            if (og + 1u == (tg + 1u) * nx) xb_add(&bar[XB_TOPGEN], 1u);
            else XB_SPIN(xb_ld(&bar[XB_TOPGEN]) == tg, bar);
            __builtin_amdgcn_fence(__ATOMIC_ACQUIRE, "agent");
            xb_add(&bar[XB_XGEN(b.x)], 1u);
            asm volatile("s_waitcnt vmcnt(0)" ::: "memory");
        } else {
            XB_SPIN(xb_ld(&bar[XB_XGEN(b.x)]) == gen, bar);
            __builtin_amdgcn_fence(__ATOMIC_ACQUIRE, "agent");
            asm volatile("s_waitcnt vmcnt(0)" ::: "memory");
        }
    }
    __syncthreads();
}

constexpr size_t WS_BAR = 1310720;
struct Args { const float* in[20]; float* out; unsigned char* ws; int ph_lo, ph_hi; };

__device__ __forceinline__ void p0_transpose_item(const float* W, int ldw, int K, int nblk, bf16* WT, LAS float* scr, int item, int lane) {
    const int kb = item / nblk, nb = item % nblk, k0 = 64 * kb, n0 = 32 * nb;
#pragma unroll 8
    for (int i = 0; i < 32; ++i) { const int kk = 2 * i + (lane >> 5); scr[kk * 33 + (lane & 31)] = W[(size_t)(k0 + kk) * ldw + n0 + (lane & 31)]; }
    asm volatile("s_waitcnt lgkmcnt(0)" ::: "memory");
    const int c = lane & 7;
#pragma unroll
    for (int j = 0; j < 4; ++j) { const int n = (lane >> 3) + 8 * j; const LAS float* s = scr + (8 * c) * 33 + n;
        u32x4 o; o.x = cvt_pk_bf16(s[0 * 33], s[1 * 33]); o.y = cvt_pk_bf16(s[2 * 33], s[3 * 33]); o.z = cvt_pk_bf16(s[4 * 33], s[5 * 33]); o.w = cvt_pk_bf16(s[6 * 33], s[7 * 33]);
        *(u32x4*)(WT + (size_t)(n0 + n) * K + k0 + 8 * c) = o; }
    asm volatile("s_waitcnt lgkmcnt(0)" ::: "memory");
}

__device__ __forceinline__ void p0_prologue(const Args& a, LAS unsigned char* lds, int tid, int lane, int wave) {
    unsigned char* ws = a.ws;
    const int gw = blockIdx.x * NWAVES + wave, NGW = gridDim.x * NWAVES;
    const int gt = blockIdx.x * 512 + tid, NGT = gridDim.x * 512;
    { float* r1 = (float*)(ws + WS_RSS1); for (int i = gt; i < 2 * M; i += NGT) r1[i] = 0.f;
      float* sq = (float*)(ws + WS_SSQ); for (int i = gt; i < 2 * M; i += NGT) sq[i] = 0.f;
      float* lb = (float*)(ws + WS_LB); const float* lg = a.in[5];
      for (int i = gt; i < 1024; i += NGT) { const float l0 = lg[i], l1 = lg[1024 + i]; lb[i] = 1.0f / (1.0f + __expf(l1 - l0)); } }
    LAS f32x4* wdt = (LAS f32x4*)lds;
    for (int idx = tid; idx < 4096; idx += 512) { const int ln = idx & 63, c4 = (idx >> 6) & 3, ji = idx >> 8, j = ji >> 2, i = ji & 3, k = 256 * j + 4 * ln + i;
        wdt[idx] = *(const f32x4*)(a.in[7] + (size_t)k * LDWIN + NIN + 4 * c4); }
    __syncthreads();
    LAS float* scr = (LAS float*)(lds + 65536 + wave * 8448);
    constexpr int I_IN = (D / 64) * (NIN / 32), I_OUT = (DMIX / 64) * (D / 32), I_UP = (D / 64) * (FF / 32), I_DN = (FF / 64) * (D / 32);
    for (int it = gw; it < I_IN + I_OUT + I_UP + I_DN; it += NGW) {
        int r = it;
        if (r < I_IN) { p0_transpose_item(a.in[7], LDWIN, D, NIN / 32, (bf16*)(ws + WS_WIN), scr, r, lane); continue; } r -= I_IN;
        if (r < I_OUT) { p0_transpose_item(a.in[15], D, DMIX, D / 32, (bf16*)(ws + WS_WOUT), scr, r, lane); continue; } r -= I_OUT;
        if (r < I_UP) { p0_transpose_item(a.in[17], FF, D, FF / 32, (bf16*)(ws + WS_WUP), scr, r, lane); continue; } r -= I_UP;
        p0_transpose_item(a.in[18], D, FF, D / 32, (bf16*)(ws + WS_WDN), scr, r, lane);
    }
    bf16* XN = (bf16*)(ws + WS_XN); float* DT = (float*)(ws + WS_DT);
    f32x4 gl[4];
#pragma unroll
    for (int j = 0; j < 4; ++j) gl[j] = ((const f32x4*)a.in[6])[lane + 64 * j];
    const float dtb = a.in[11][lane & 15];
    for (int grp = gw; grp < M / 4; grp += NGW) {
        const int r0 = grp * 4;
        f32x4 v[4][4];
#pragma unroll
        for (int r = 0; r < 4; ++r) { const int row = r0 + r; const f32x4* xr = (const f32x4*)((row < MP) ? a.in[0] + (size_t)row * D : a.in[1] + (size_t)(row - MP) * D);
#pragma unroll
            for (int j = 0; j < 4; ++j) v[r][j] = xr[lane + 64 * j]; }
#pragma unroll
        for (int r = 0; r < 4; ++r) { float s = 0.f;
#pragma unroll
            for (int j = 0; j < 4; ++j) s += (v[r][j][0] * v[r][j][0] + v[r][j][1] * v[r][j][1]) + (v[r][j][2] * v[r][j][2] + v[r][j][3] * v[r][j][3]);
            const float rstd = __builtin_amdgcn_rsqf(wave_sum(s) * (1.0f / D) + EPS);
            u32x2* o8 = (u32x2*)(XN + (size_t)(r0 + r) * D);
#pragma unroll
            for (int j = 0; j < 4; ++j) { v[r][j] = v[r][j] * rstd * gl[j]; u32x2 w; w.x = cvt_pk_bf16(v[r][j][0], v[r][j][1]); w.y = cvt_pk_bf16(v[r][j][2], v[r][j][3]); o8[lane + 64 * j] = w; } }
        float ac[64];
#pragma unroll
        for (int i = 0; i < 64; ++i) ac[i] = 0.f;
#pragma unroll
        for (int j = 0; j < 4; ++j)
#pragma unroll
            for (int i = 0; i < 4; ++i)
#pragma unroll
                for (int c4 = 0; c4 < 4; ++c4) { const f32x4 w = wdt[((j * 4 + i) * 4 + c4) * 64 + lane];
#pragma unroll
                    for (int r = 0; r < 4; ++r) { const float hv = v[r][j][i];
                        ac[r * 16 + c4 * 4 + 0] += hv * w[0]; ac[r * 16 + c4 * 4 + 1] += hv * w[1]; ac[r * 16 + c4 * 4 + 2] += hv * w[2]; ac[r * 16 + c4 * 4 + 3] += hv * w[3]; } }
#pragma unroll
        for (int half = 32; half >= 1; half >>= 1) {
            const bool up = (lane & half) != 0;
#pragma unroll
            for (int i = 0; i < half; ++i) { const float send = up ? ac[i] : ac[i + half], keep = up ? ac[i + half] : ac[i]; ac[i] = keep + __shfl_xor(send, half); }
        }
        const float xr_ = ac[0] + dtb;
        DT[(size_t)r0 * 16 + lane] = fmaxf(xr_, 0.f) + log1pf(__expf(-fabsf(xr_)));
    }
}

__device__ __forceinline__ void p6_final(const Args& a, int lane, int wave) {
    float* Y = a.out + O_Y;
    const int gw = blockIdx.x * NWAVES + wave, NGW = gridDim.x * NWAVES;
    f32x4 gl[4];
#pragma unroll
    for (int j = 0; j < 4; ++j) gl[j] = ((const f32x4*)a.in[19])[lane + 64 * j];
    for (int row = gw; row < M; row += NGW) {
        f32x4* p = (f32x4*)(Y + (size_t)row * D); f32x4 v[4]; float ss = 0.f;
#pragma unroll
        for (int j = 0; j < 4; ++j) { v[j] = p[lane + 64 * j];
            if (row >= MP) { const f32x4* pp = (const f32x4*)((const float*)(a.ws + WS_PART) + (size_t)(row - MP) * D) + lane + 64 * j;
                v[j] = v[j] + (((pp[0] + pp[262144]) + (pp[524288] + pp[786432])) + ((pp[1048576] + pp[1310720]) + (pp[1572864] + pp[1835008]))); }
            ss += (v[j][0] * v[j][0] + v[j][1] * v[j][1]) + (v[j][2] * v[j][2] + v[j][3] * v[j][3]); }
        const float rs = __builtin_amdgcn_rsqf(wave_sum(ss) * (1.0f / D) + EPS);
#pragma unroll
        for (int j = 0; j < 4; ++j) p[lane + 64 * j] = v[j] * rs * gl[j];
    }
}

__device__ __forceinline__ void conv_act_elem(const bf16* XBC, const float* conv0, const float* cw, const float* cb, bf16* XBA, size_t idx) {
    const int row = (int)(idx / 1536), col = (int)(idx % 1536);
    float acc = cb[col];
#pragma unroll
    for (int j = 0; j < 4; ++j) { const int off = j - 3; float xv;
        if (row < MP) { const int t = row & 2047; xv = (t + off >= 0) ? bf2f(XBC[(size_t)(row + off) * 1536 + col]) : 0.f; }
        else { const int r = row - MP, b = r >> 3, t = r & 7; xv = (t + off >= 0) ? bf2f(XBC[(size_t)(row + off) * 1536 + col]) : conv0[(size_t)(b * 3 + (3 + t + off)) * 1536 + col]; }
        acc += cw[j * 1536 + col] * xv; }
    XBA[idx] = (bf16)(cvt_pk_bf16(silu_f(acc), 0.f) & 0xffffu);
}
__device__ __forceinline__ void simple_hgrn(LAS float* red, int u, int v, bf16* QZ, const unsigned short* F, const bf16* I, const bf16* G, const float* S0, const float* hgn, float* outP, float* outS) {
    const int lane = v & 63, wv = v >> 6;
    int row0, L, h; const float* s0 = nullptr; float* so;
    if (u < 64) { h = u & 7; row0 = (u >> 3) * 2048; L = 2048; so = outP + (size_t)u * 16384; }
    else { const int us = u - 64; h = us & 7; row0 = MP + (us >> 3) * 8; L = 8; s0 = S0 + (size_t)us * 16384; so = outS + (size_t)us * 16384; }
    float S[128];
#pragma unroll
    for (int k = 0; k < 128; ++k) S[k] = s0 ? s0[k * 128 + v] : 0.f;
    for (int t = 0; t < L; ++t) {
        const size_t row = row0 + t; const float vv = bf2f(I[row * 1024 + h * 128 + v]); float o = 0.f;
#pragma unroll
        for (int k = 0; k < 128; ++k) { const float f = __expf(h2f(F[row * 1024 + h * 128 + k])); S[k] = f * S[k] + (1.0f - f) * vv; o += S[k] * bf2f(QZ[row * 2048 + h * 128 + k]); }
        float ss = wave_sum(o * o); if (lane == 0) red[wv] = ss; __syncthreads(); ss = red[0] + red[1];
        const float res = o * rsqrtf(ss * (1.0f / 128.0f) + EPS) * hgn[h * 128 + v] * bf2f(G[row * 1024 + h * 128 + v]);
        __syncthreads();
        QZ[row * 2048 + h * 128 + v] = (bf16)(cvt_pk_bf16(res, 0.f) & 0xffffu);
    }
#pragma unroll
    for (int k = 0; k < 128; ++k) so[k * 128 + v] = S[k];
}
__device__ __forceinline__ void simple_ssd(LAS float* red, int u, bf16* QZ, const bf16* XBA, const float* DT, const float* S0, const float* a_log, const float* d_skip, const float* mnorm, float* outP, float* outS) {
    const int tid = threadIdx.x, lane = tid & 63, wv = tid >> 6, p = lane;
    int row0, L, b, g; const float* s0 = nullptr; float* so;
    if (u < 16) { b = u >> 1; g = u & 1; row0 = b * 2048; L = 2048; }
    else { const int us = u - 16; b = us >> 1; g = us & 1; row0 = MP + b * 8; L = 8; }
    const int h = g * 8 + wv, ch = h * 64 + p;
    if (u < 16) so = outP + ((size_t)(b * 16 + h) * 64 + p) * 128; else { s0 = S0 + ((size_t)(b * 16 + h) * 64 + p) * 128; so = outS + ((size_t)(b * 16 + h) * 64 + p) * 128; }
    float S[128];
#pragma unroll
    for (int n = 0; n < 128; ++n) S[n] = s0 ? s0[n] : 0.f;
    const float A = -__expf(a_log[h]), Dk = d_skip[h], gain = mnorm[ch];
    for (int t = 0; t < L; ++t) {
        const size_t row = row0 + t; const float dt = DT[row * 16 + h], xs = bf2f(XBA[row * 1536 + ch]), dec = __expf(dt * A), xdt = xs * dt; float y = 0.f;
        const bf16* Bp = XBA + row * 1536 + 1024 + g * 128; const bf16* Cp = XBA + row * 1536 + 1280 + g * 128;
#pragma unroll
        for (int n = 0; n < 128; ++n) { S[n] = dec * S[n] + xdt * bf2f(Bp[n]); y += S[n] * bf2f(Cp[n]); }
        y += Dk * xs; y *= bf2f(QZ[row * 2048 + 1024 + ch]);
        float ss = wave_sum(y * y); if (lane == 0) red[wv] = ss; __syncthreads();
        ss = ((red[0] + red[1]) + (red[2] + red[3])) + ((red[4] + red[5]) + (red[6] + red[7]));
        const float res = y * rsqrtf(ss * (1.0f / 512.0f) + EPS) * gain;
        __syncthreads();
        QZ[row * 2048 + 1024 + ch] = (bf16)(cvt_pk_bf16(res, 0.f) & 0xffffu);
    }
#pragma unroll
    for (int n = 0; n < 128; ++n) so[n] = S[n];
}
__device__ __forceinline__ unsigned pkbf(float lo, float hi) { unsigned r; asm("v_cvt_pk_bf16_f32 %0, %1, %2" : "=v"(r) : "v"(lo), "v"(hi)); return r; }
__device__ __forceinline__ bf16x8 pack8(f32x4 a, f32x4 b) { u32x4 w; w.x = pkbf(a[0], a[1]); w.y = pkbf(a[2], a[3]); w.z = pkbf(b[0], b[1]); w.w = pkbf(b[2], b[3]); return __builtin_bit_cast(bf16x8, w); }
__device__ __forceinline__ float lo16(unsigned u) { return __uint_as_float(u << 16); }
__device__ __forceinline__ float hi16(unsigned u) { return __uint_as_float(u & 0xffff0000u); }
__device__ __forceinline__ void st_sc1_8(void* p, u32x2 v) { __hip_atomic_store((unsigned long long*)p, (unsigned long long)v.x | ((unsigned long long)v.y << 32), __ATOMIC_RELAXED, __HIP_MEMORY_SCOPE_AGENT); }
__device__ __forceinline__ void st_sc1_16(void* p, u32x4 v) { asm volatile("global_store_dwordx4 %0, %1, off sc1\n\ts_nop 1" :: "v"(p), "v"(v) : "memory"); }
#define MFMA16(a, b, c) __builtin_amdgcn_mfma_f32_16x16x32_bf16((a), (b), (c), 0, 0, 0)
#define WG_BAR() do { asm volatile("s_waitcnt lgkmcnt(0)" ::: "memory"); __builtin_amdgcn_s_barrier(); asm volatile("" ::: "memory"); } while (0)
constexpr int E_QD = 0, E_KD = 8704, E_KET = 17408, E_VT = 27648, E_VTE = 68608, E_TOT = 109568, E_DEC = 113664, E_RED = 114176, E_CUM = 115200, E_DTV = 116224, E_TOTH = 117248;
constexpr int QP = 272, KP = 80;

struct GlaP {
    int row0, ntok, nch, seq_t0, head, half, samp_b;
    const float* Sinit; int init_lay;
    int nprev; const float* Dprev;
    float* Sout; int out_lay;
    float* Dout;
};

template <int MODE, bool OUT>
__device__ __forceinline__ void gla_unit(LAS unsigned char* lds, const GlaP P, const Args& args, int lane, int w) {
    constexpr int NV = MODE == 0 ? 1 : 2;
    const int fr = lane & 15, fq = lane >> 4;
    const int vbase = MODE == 0 ? 16 * w : 32 * w;
    const int hl = w >> 1;
    unsigned char* ws = args.ws;
    bf16* QZ = (bf16*)(ws + WS_QZ);
    const unsigned short* Fb = (const unsigned short*)(ws + WS_F);
    const bf16* Ib = (const bf16*)(args.out) + (size_t)M * 1024;
    const bf16* Gb = (const bf16*)(args.out);
    const bf16* XBC = (const bf16*)(ws + WS_XBC);
    const float* DT = (const float*)(ws + WS_DT);
    const int posoff = 2 * (8 * (w & 3) + 4 * (w >> 2));
    LAS float* TOT = (LAS float*)(lds + E_TOT); LAS float* DEC = (LAS float*)(lds + E_DEC); LAS float* RED = (LAS float*)(lds + E_RED);
    LAS float* CUM = (LAS float*)(lds + E_CUM); LAS float* DTV = (LAS float*)(lds + E_DTV); LAS float* TOTH = (LAS float*)(lds + E_TOTH);
    f32x4 S[8][NV];
    if (P.init_lay == 0) {
#pragma unroll
        for (int kt = 0; kt < 8; ++kt)
#pragma unroll
            for (int vt = 0; vt < NV; ++vt) S[kt][vt] = (f32x4){0.f, 0.f, 0.f, 0.f};
    } else if (P.init_lay == 2) {
        const f32x4* sp = (const f32x4*)P.Sinit;
#pragma unroll
        for (int kt = 0; kt < 8; ++kt)
#pragma unroll
            for (int vt = 0; vt < NV; ++vt) S[kt][vt] = sp[((w * 8 + kt) * NV + vt) * 64 + lane];
    } else {
        if constexpr (MODE == 0) {
#pragma unroll
            for (int kt = 0; kt < 8; ++kt)
#pragma unroll
                for (int r = 0; r < 4; ++r) S[kt][0][r] = P.Sinit[(size_t)(16 * kt + 4 * fq + r) * 128 + 16 * w + fr];
        } else {
            const float* sb = P.Sinit + (size_t)hl * 8192 + (size_t)(32 * (w & 1)) * 128;
#pragma unroll
            for (int kt = 0; kt < 8; ++kt)
#pragma unroll
                for (int vt = 0; vt < NV; ++vt) S[kt][vt] = *(const f32x4*)(sb + (size_t)(16 * vt + fr) * 128 + 16 * kt + 4 * fq);
        }
    }
    float slog0 = 0.f, slog1 = 0.f;
    const int hh = MODE == 0 ? P.head : 8 * P.head + 4 * P.half + hl;
    float A_h = 0.f, Dsk = 0.f;
    if constexpr (MODE == 1) { A_h = -__expf(args.in[12][hh]); Dsk = args.in[13][hh]; }

    unsigned rawq[4] = {0u, 0u, 0u, 0u}, rawf[4] = {0u, 0u, 0u, 0u}, rawv[4] = {0u, 0u, 0u, 0u};
#define HG_PREFETCH(cc_) do { if constexpr (MODE == 0) { _Pragma("unroll") for (int i_ = 0; i_ < 4; ++i_) { const int t_ = 32 * (cc_) + 4 * w + i_; \
        if (t_ < P.ntok) { const size_t row_ = (size_t)(P.row0 + t_); rawf[i_] = *(const unsigned*)(Fb + row_ * 1024 + hh * 128 + 2 * lane); rawv[i_] = *(const unsigned*)(Ib + row_ * 1024 + hh * 128 + 2 * lane); \
            rawq[i_] = OUT ? *(const unsigned*)(QZ + row_ * 2048 + hh * 128 + 2 * lane) : 0u; } \
        else { rawf[i_] = 0u; rawv[i_] = 0u; rawq[i_] = 0u; } } } } while (0)
    HG_PREFETCH(0);
    const bool usepf = MODE == 1 && P.samp_b < 0;
    unsigned pC[7] = {0u, 0u, 0u, 0u, 0u, 0u, 0u};
    unsigned pB[7] = {0u, 0u, 0u, 0u, 0u, 0u, 0u}, pX[2][7] = {{0u, 0u, 0u, 0u, 0u, 0u, 0u}, {0u, 0u, 0u, 0u, 0u, 0u, 0u}}; float pdt = 0.f;
#define SS_PREFETCH(cc_) do { if constexpr (MODE == 1) { if (usepf) { _Pragma("unroll") for (int j_ = 0; j_ < 7; ++j_) { const int tr_ = 32 * (cc_) + 4 * w - 3 + j_; \
        if (tr_ < P.ntok && tr_ + P.seq_t0 >= 0) { const bf16* rp_ = XBC + (size_t)(P.row0 + tr_) * 1536; pB[j_] = *(const unsigned*)(rp_ + 1024 + P.head * 128 + 2 * lnq); if (OUT) pC[j_] = *(const unsigned*)(rp_ + 1280 + P.head * 128 + 2 * lnq); \
            pX[0][j_] = *(const unsigned*)(rp_ + P.head * 512 + 256 * P.half + 2 * lnq); pX[1][j_] = *(const unsigned*)(rp_ + P.head * 512 + 256 * P.half + 128 + 2 * lnq); } \
        else { pB[j_] = 0u; pC[j_] = 0u; pX[0][j_] = 0u; pX[1][j_] = 0u; } } \
        { const int tk_ = 32 * (cc_) + (lnq & 31); pdt = (tk_ < P.ntok) ? DT[(size_t)(P.row0 + tk_) * 16 + hh] : 0.f; } } } } while (0)
    { int lnq = lane; asm volatile("" : "+v"(lnq)); SS_PREFETCH(0); }
    u32x2 gpre[2] = {{0u, 0u}, {0u, 0u}};
    for (int c = 0; c < P.nch; ++c) {
        const int tb = 32 * c + 4 * w;
        if constexpr (MODE == 0) {
            float q[4][2], lf[4][2], vv[4][2];
#pragma unroll
            for (int i = 0; i < 4; ++i) {
                lf[i][0] = h2f((unsigned short)(rawf[i] & 0xffffu)); lf[i][1] = h2f((unsigned short)(rawf[i] >> 16));
                vv[i][0] = lo16(rawv[i]); vv[i][1] = hi16(rawv[i]);
                q[i][0] = lo16(rawq[i]); q[i][1] = hi16(rawq[i]);
            }
            if (c + 1 < P.nch) HG_PREFETCH(c + 1);
            float cs[4][2];
#pragma unroll
            for (int e = 0; e < 2; ++e) { cs[0][e] = lf[0][e]; cs[1][e] = cs[0][e] + lf[1][e]; cs[2][e] = cs[1][e] + lf[2][e]; cs[3][e] = cs[2][e] + lf[3][e]; }
            *(LAS f32x2*)(TOT + w * 128 + 2 * lane) = (f32x2){cs[3][0], cs[3][1]};
            WG_BAR();
            float pre[2] = {0.f, 0.f}, tot[2] = {0.f, 0.f};
#pragma unroll
            for (int g = 0; g < 8; ++g) { const f32x2 tv = *(const LAS f32x2*)(TOT + g * 128 + 2 * lane); tot[0] += tv.x; tot[1] += tv.y; if (g < w) { pre[0] += tv.x; pre[1] += tv.y; } }
            float qd[4][2], kd[4][2], ke[4][2];
#pragma unroll
            for (int i = 0; i < 4; ++i)
#pragma unroll
                for (int e = 0; e < 2; ++e) { const float cum = pre[e] + cs[i][e], kk = 1.0f - __expf(lf[i][e]);
                    qd[i][e] = q[i][e] * __expf(cum); kd[i][e] = kk * __expf(-cum); ke[i][e] = kk * __expf(tot[e] - cum); }
            if (OUT) {
#pragma unroll
                for (int i = 0; i < 4; ++i) { *(LAS unsigned*)(lds + E_QD + (4 * w + i) * QP + 4 * lane) = pkbf(qd[i][0], qd[i][1]); *(LAS unsigned*)(lds + E_KD + (4 * w + i) * QP + 4 * lane) = pkbf(kd[i][0], kd[i][1]); }
            }
#pragma unroll
            for (int e = 0; e < 2; ++e) {
                u32x2 a; a.x = pkbf(ke[0][e], ke[1][e]); a.y = pkbf(ke[2][e], ke[3][e]); *(LAS u32x2*)(lds + E_KET + (2 * lane + e) * KP + posoff) = a;
                u32x2 b; b.x = pkbf(vv[0][e], vv[1][e]); b.y = pkbf(vv[2][e], vv[3][e]); *(LAS u32x2*)(lds + E_VT + (2 * lane + e) * KP + posoff) = b;
            }
            if (w == 0) { *(LAS f32x2*)(DEC + 2 * lane) = (f32x2){__expf(tot[0]), __expf(tot[1])}; slog0 += tot[0]; slog1 += tot[1]; }
            WG_BAR();
            if (OUT) {
#pragma unroll
                for (int tt = 0; tt < 2; ++tt) { const int tok = 32 * c + 16 * tt + fr; gpre[tt] = *(const u32x2*)(Gb + (size_t)(P.row0 + (tok < P.ntok ? tok : 0)) * 1024 + hh * 128 + vbase + 4 * fq); }
            }
        } else {
            const int g = P.head;
            int lnq = lane; asm volatile("" : "+v"(lnq));
            auto ldraw = [&](int col, int tokrel, float& x0, float& x1) {
                if (tokrel >= P.ntok) { x0 = 0.f; x1 = 0.f; }
                else if (tokrel + P.seq_t0 >= 0) { const unsigned a = *(const unsigned*)(XBC + (size_t)(P.row0 + tokrel) * 1536 + col); x0 = lo16(a); x1 = hi16(a); }
                else if (P.samp_b >= 0) { const f32x2 a = *(const f32x2*)(args.in[4] + (size_t)(P.samp_b * 3 + 3 + tokrel) * 1536 + col); x0 = a.x; x1 = a.y; }
                else { x0 = 0.f; x1 = 0.f; }
            };
            auto convact = [&](int col, float (&o)[4][2]) {
                float rr[7][2];
#pragma unroll
                for (int j = 0; j < 7; ++j) ldraw(col, tb - 3 + j, rr[j][0], rr[j][1]);
                const f32x2 cb = *(const f32x2*)(args.in[10] + col);
                f32x2 cw[4];
#pragma unroll
                for (int j = 0; j < 4; ++j) cw[j] = *(const f32x2*)(args.in[9] + j * 1536 + col);
#pragma unroll
                for (int i = 0; i < 4; ++i) {
                    float a0 = cb.x, a1 = cb.y;
#pragma unroll
                    for (int j = 0; j < 4; ++j) { a0 += cw[j].x * rr[i + j][0]; a1 += cw[j].y * rr[i + j][1]; }
                    const bool ok = (tb + i) < P.ntok;
                    o[i][0] = ok ? silu_f(a0) : 0.f; o[i][1] = ok ? silu_f(a1) : 0.f;
                }
            };
            auto convraw = [&](int col, const unsigned (&raw)[7], float (&o)[4][2]) {
                const f32x2 cb = *(const f32x2*)(args.in[10] + col);
                f32x2 cw[4];
#pragma unroll
                for (int j = 0; j < 4; ++j) cw[j] = *(const f32x2*)(args.in[9] + j * 1536 + col);
#pragma unroll
                for (int i = 0; i < 4; ++i) {
                    float a0 = cb.x, a1 = cb.y;
#pragma unroll
                    for (int j = 0; j < 4; ++j) { a0 += cw[j].x * lo16(raw[i + j]); a1 += cw[j].y * hi16(raw[i + j]); }
                    const bool ok = (tb + i) < P.ntok;
                    o[i][0] = ok ? silu_f(a0) : 0.f; o[i][1] = ok ? silu_f(a1) : 0.f;
                }
            };
            {
                const int l = lane & 31, tok = 32 * c + l;
                const float dt = usepf ? pdt : ((tok < P.ntok) ? DT[(size_t)(P.row0 + tok) * 16 + hh] : 0.f);
                float x = dt * A_h;
#pragma unroll
                for (int o = 1; o < 32; o <<= 1) { const float y = __shfl_up(x, o, 32); if (l >= o) x += y; }
                if (lane < 32) { CUM[hl * 32 + l] = x; DTV[hl * 32 + l] = dt; }
                const float th = __shfl(x, 31, 32);
                if (lane == 0) TOTH[hl] = th;
                slog0 += th;
            }
            {
                float ba[4][2];
                if (usepf) convraw(1024 + g * 128 + 2 * lnq, pB, ba); else convact(1024 + g * 128 + 2 * lnq, ba);
                u32x2 a0, a1; a0.x = pkbf(ba[0][0], ba[1][0]); a0.y = pkbf(ba[2][0], ba[3][0]); a1.x = pkbf(ba[0][1], ba[1][1]); a1.y = pkbf(ba[2][1], ba[3][1]);
                *(LAS u32x2*)(lds + E_KET + (2 * lane) * KP + posoff) = a0; *(LAS u32x2*)(lds + E_KET + (2 * lane + 1) * KP + posoff) = a1;
                if (OUT) {
#pragma unroll
                    for (int i = 0; i < 4; ++i) *(LAS unsigned*)(lds + E_KD + (4 * w + i) * QP + 4 * lane) = pkbf(ba[i][0], ba[i][1]);
                    float ca[4][2];
                    if (usepf) convraw(1280 + g * 128 + 2 * lnq, pC, ca); else convact(1280 + g * 128 + 2 * lnq, ca);
#pragma unroll
                    for (int i = 0; i < 4; ++i) *(LAS unsigned*)(lds + E_QD + (4 * w + i) * QP + 4 * lane) = pkbf(ca[i][0], ca[i][1]);
                }
            }
            WG_BAR();
#pragma unroll 1
            for (int jj = 0; jj < 2; ++jj) {
                const int cl = 2 * (lnq + 64 * jj), hc = cl >> 6;
                float xa[4][2];
                if (usepf) { if (jj == 0) convraw(g * 512 + 256 * P.half + cl, pX[0], xa); else convraw(g * 512 + 256 * P.half + cl, pX[1], xa); } else convact(g * 512 + 256 * P.half + cl, xa);
                const float th = TOTH[hc];
                float xd[4][2], xe[4][2];
#pragma unroll
                for (int i = 0; i < 4; ++i) { const float dtv = DTV[hc * 32 + 4 * w + i], te = __expf(th - CUM[hc * 32 + 4 * w + i]);
                    xd[i][0] = xa[i][0] * dtv; xd[i][1] = xa[i][1] * dtv; xe[i][0] = xd[i][0] * te; xe[i][1] = xd[i][1] * te; }
#pragma unroll
                for (int e = 0; e < 2; ++e) {
                    u32x2 b; b.x = pkbf(xe[0][e], xe[1][e]); b.y = pkbf(xe[2][e], xe[3][e]); *(LAS u32x2*)(lds + E_VTE + (cl + e) * KP + posoff) = b;
                    if (OUT) { u32x2 a; a.x = pkbf(xd[0][e], xd[1][e]); a.y = pkbf(xd[2][e], xd[3][e]); *(LAS u32x2*)(lds + E_VT + (cl + e) * KP + posoff) = a; }
                }
            }
            WG_BAR();
            if (c + 1 < P.nch) SS_PREFETCH(c + 1);
        }
        bf16x8 Pm[2];
        float ecum[2] = {1.f, 1.f};
        if (OUT) {
            f32x4 a00 = {0.f, 0.f, 0.f, 0.f}, a01 = a00, a11 = a00;
#pragma unroll
            for (int kk = 0; kk < 4; ++kk) {
                const bf16x8 k0 = *(const LAS bf16x8*)(lds + E_KD + fr * QP + 64 * kk + 16 * fq), k1 = *(const LAS bf16x8*)(lds + E_KD + (16 + fr) * QP + 64 * kk + 16 * fq);
                const bf16x8 q0 = *(const LAS bf16x8*)(lds + E_QD + fr * QP + 64 * kk + 16 * fq), q1 = *(const LAS bf16x8*)(lds + E_QD + (16 + fr) * QP + 64 * kk + 16 * fq);
                a00 = MFMA16(k0, q0, a00); a01 = MFMA16(k0, q1, a01); a11 = MFMA16(k1, q1, a11);
            }
            f32x4 z4 = {0.f, 0.f, 0.f, 0.f};
            if constexpr (MODE == 0) {
#pragma unroll
                for (int r = 0; r < 4; ++r) { const bool keep = (4 * fq + r) <= fr; a00[r] = keep ? a00[r] : 0.f; a11[r] = keep ? a11[r] : 0.f; }
            } else {
                const float ct0 = CUM[hl * 32 + fr], ct1 = CUM[hl * 32 + 16 + fr], dt0 = DTV[hl * 32 + fr], dt1 = DTV[hl * 32 + 16 + fr];
                const f32x4 cs0 = *(const LAS f32x4*)(CUM + hl * 32 + 4 * fq), cs1 = *(const LAS f32x4*)(CUM + hl * 32 + 16 + 4 * fq);
                const float dg0 = dt0 > 0.f ? Dsk / dt0 : 0.f, dg1 = dt1 > 0.f ? Dsk / dt1 : 0.f;
#pragma unroll
                for (int r = 0; r < 4; ++r) { const int s = 4 * fq + r; const bool keep = s <= fr, dg = s == fr;
                    const float v00 = a00[r] * __expf(fminf(ct0 - cs0[r], 0.f)), v01 = a01[r] * __expf(fminf(ct1 - cs0[r], 0.f)), v11 = a11[r] * __expf(fminf(ct1 - cs1[r], 0.f));
                    a00[r] = (keep ? v00 : 0.f) + (dg ? dg0 : 0.f); a01[r] = v01; a11[r] = (keep ? v11 : 0.f) + (dg ? dg1 : 0.f); }
                ecum[0] = __expf(ct0); ecum[1] = __expf(ct1);
            }
            Pm[0] = pack8(a00, z4); Pm[1] = pack8(a01, a11);
        }
        f32x4 o[NV][2];
#pragma unroll
        for (int vt = 0; vt < NV; ++vt) {
            asm volatile("" ::: "memory");
            const bf16x8 vtf = *(const LAS bf16x8*)(lds + E_VT + (vbase + 16 * vt + fr) * KP + 16 * fq);
            if (OUT) {
                f32x4 o0 = {0.f, 0.f, 0.f, 0.f}, o1 = o0;
#pragma unroll
                for (int j = 0; j < 4; ++j) {
                    const bf16x8 sb = pack8(S[2 * j][vt], S[2 * j + 1][vt]);
                    const u32x2 qa = *(const LAS u32x2*)(lds + E_QD + fr * QP + 64 * j + 8 * fq), qb = *(const LAS u32x2*)(lds + E_QD + fr * QP + 64 * j + 32 + 8 * fq);
                    const u32x2 qc = *(const LAS u32x2*)(lds + E_QD + (16 + fr) * QP + 64 * j + 8 * fq), qe = *(const LAS u32x2*)(lds + E_QD + (16 + fr) * QP + 64 * j + 32 + 8 * fq);
                    u32x4 t0; t0.x = qa.x; t0.y = qa.y; t0.z = qb.x; t0.w = qb.y; u32x4 t1; t1.x = qc.x; t1.y = qc.y; t1.z = qe.x; t1.w = qe.y;
                    o0 = MFMA16(sb, __builtin_bit_cast(bf16x8, t0), o0); o1 = MFMA16(sb, __builtin_bit_cast(bf16x8, t1), o1);
                }
                if constexpr (MODE == 1) { o0 = o0 * ecum[0]; o1 = o1 * ecum[1]; }
                o0 = MFMA16(vtf, Pm[0], o0); o1 = MFMA16(vtf, Pm[1], o1);
                o[vt][0] = o0; o[vt][1] = o1;
            }
            bf16x8 vte = vtf;
            if constexpr (MODE == 1) vte = *(const LAS bf16x8*)(lds + E_VTE + (vbase + 16 * vt + fr) * KP + 16 * fq);
            float dsc = 1.f;
            if constexpr (MODE == 1) dsc = __expf(TOTH[hl]);
#pragma unroll
            for (int kt = 0; kt < 8; ++kt) {
                const bf16x8 kf = *(const LAS bf16x8*)(lds + E_KET + (16 * kt + fr) * KP + 16 * fq);
                f32x4 sc;
                if constexpr (MODE == 0) sc = S[kt][vt] * *(const LAS f32x4*)(DEC + 16 * kt + 4 * fq); else sc = S[kt][vt] * dsc;
                S[kt][vt] = MFMA16(kf, vte, sc);
            }
        }
        if (OUT) {
            if constexpr (MODE == 0) {
                f32x4 gz[2]; bool val[2]; size_t rowt[2];
#pragma unroll
                for (int tt = 0; tt < 2; ++tt) {
                    const int tok = 32 * c + 16 * tt + fr; val[tt] = tok < P.ntok; rowt[tt] = (size_t)(P.row0 + (val[tt] ? tok : 0));
                    const u32x2 gg = gpre[tt];
                    gz[tt] = (f32x4){lo16(gg.x), hi16(gg.x), lo16(gg.y), hi16(gg.y)};
                    const f32x4 y = o[0][tt]; float ss = (y[0] * y[0] + y[1] * y[1]) + (y[2] * y[2] + y[3] * y[3]);
                    ss += __shfl_xor(ss, 16); ss += __shfl_xor(ss, 32);
                    if (fq == 0) RED[(16 * tt + fr) * 8 + w] = ss;
                }
                WG_BAR();
                const f32x4 gn = *(const f32x4*)(args.in[8] + hh * 128 + vbase + 4 * fq);
#pragma unroll
                for (int tt = 0; tt < 2; ++tt) {
                    const f32x4 r0 = *(const LAS f32x4*)(RED + (16 * tt + fr) * 8), r1 = *(const LAS f32x4*)(RED + (16 * tt + fr) * 8 + 4);
                    const float tot = ((r0[0] + r0[1]) + (r0[2] + r0[3])) + ((r1[0] + r1[1]) + (r1[2] + r1[3]));
                    const float rstd = __builtin_amdgcn_rsqf(tot * (1.0f / 128.0f) + EPS);
                    const f32x4 res = o[0][tt] * rstd * gn * gz[tt];
                    u32x2 wv; wv.x = pkbf(res[0], res[1]); wv.y = pkbf(res[2], res[3]);
                    if (val[tt]) *(u32x2*)(QZ + rowt[tt] * 2048 + hh * 128 + vbase + 4 * fq) = wv;
                }
            } else {
                float* SSQ = (float*)(ws + WS_SSQ);
#pragma unroll
                for (int tt = 0; tt < 2; ++tt) {
                    const int tok = 32 * c + 16 * tt + fr; const bool val = tok < P.ntok; const size_t row = (size_t)(P.row0 + (val ? tok : 0));
                    float ss = 0.f;
#pragma unroll
                    for (int vt = 0; vt < NV; ++vt) {
                        bf16* zp = QZ + row * 2048 + 1024 + P.head * 512 + 256 * P.half + vbase + 16 * vt + 4 * fq;
                        const u32x2 gg = *(const u32x2*)zp;
                        const f32x4 y = o[vt][tt] * (f32x4){lo16(gg.x), hi16(gg.x), lo16(gg.y), hi16(gg.y)};
                        u32x2 wv; wv.x = pkbf(y[0], y[1]); wv.y = pkbf(y[2], y[3]);
                        const f32x4 yr = {lo16(wv.x), hi16(wv.x), lo16(wv.y), hi16(wv.y)};
                        ss += (yr[0] * yr[0] + yr[1] * yr[1]) + (yr[2] * yr[2] + yr[3] * yr[3]);
                        if (val) *(u32x2*)zp = wv;
                    }
                    ss += __shfl_xor(ss, 16); ss += __shfl_xor(ss, 32);
                    if (fq == 0 && val) unsafeAtomicAdd(SSQ + row * 2 + P.head, ss);
                }
                WG_BAR();
            }
        } else {
            WG_BAR();
        }
    }
    if (P.out_lay == 2) {
        f32x4* sp = (f32x4*)P.Sout;
#pragma unroll
        for (int kt = 0; kt < 8; ++kt)
#pragma unroll
            for (int vt = 0; vt < NV; ++vt) sp[((w * 8 + kt) * NV + vt) * 64 + lane] = S[kt][vt];
    } else if (P.out_lay == 1) {
        if constexpr (MODE == 0) {
#pragma unroll
            for (int kt = 0; kt < 8; ++kt)
#pragma unroll
                for (int r = 0; r < 4; ++r) P.Sout[(size_t)(16 * kt + 4 * fq + r) * 128 + 16 * w + fr] = S[kt][0][r];
        } else {
            float* sb = P.Sout + (size_t)hl * 8192 + (size_t)(32 * (w & 1)) * 128;
#pragma unroll
            for (int kt = 0; kt < 8; ++kt)
#pragma unroll
                for (int vt = 0; vt < NV; ++vt) *(f32x4*)(sb + (size_t)(16 * vt + fr) * 128 + 16 * kt + 4 * fq) = S[kt][vt];
        }
    }
    if (P.Dout) {
        if constexpr (MODE == 0) { if (w == 0) *(f32x2*)(P.Dout + 2 * lane) = (f32x2){__expf(slog0), __expf(slog1)}; }
        else { if (lane == 0 && (w & 1) == 0) P.Dout[hl] = __expf(slog0); }
    }
    (void)slog1;
}
#ifndef ENG_H
#define ENG_H 1
#endif
#ifndef ENG_S
#define ENG_S 1
#endif

__device__ __forceinline__ float* hseg_slot(unsigned char* ws, int bh, int s) { return (float*)(ws + WS_HSEG) + ((size_t)bh * 3 + s) * 16384; }
__device__ __forceinline__ float* sseg_slot(unsigned char* ws, int bg, int s) { return (float*)(ws + WS_SSEG) + ((size_t)bg * 7 + s) * 32768; }

__device__ __forceinline__ void phase_2a(LAS unsigned char* lds, const Args& args, int lane, int w) {
    unsigned char* ws = args.ws;
    for (int i = blockIdx.x; i < 256; i += gridDim.x) {
        if (ENG_H && i < 192) {
            const int bh = i / 3, seg = i % 3;
            GlaP p; p.row0 = (bh >> 3) * 2048 + seg * 512; p.ntok = 512; p.nch = 16; p.seq_t0 = seg * 512; p.head = bh & 7; p.half = 0; p.samp_b = -1;
            p.Sinit = nullptr; p.init_lay = 0; p.Sout = hseg_slot(ws, bh, seg); p.out_lay = 2; p.Dout = (float*)(ws + WS_HD) + (bh * 3 + seg) * 128;
            gla_unit<0, false>(lds, p, args, lane, w);
        }
        const int j0 = (i >= 192) ? 2 * (i - 192) : (i < 96 ? 128 + i : 0), nj = !ENG_S ? 0 : (i >= 192) ? 2 : (i < 96 ? 1 : 0);
        for (int j = j0; j < j0 + nj; ++j) {
            const int u = j / 7, seg = j % 7, b = u >> 2, g = (u >> 1) & 1;
            GlaP p; p.row0 = b * 2048 + seg * 256; p.ntok = 256; p.nch = 8; p.seq_t0 = seg * 256; p.head = g; p.half = u & 1; p.samp_b = -1;
            p.Sinit = nullptr; p.init_lay = 0; p.Sout = sseg_slot(ws, u, seg); p.out_lay = 2; p.Dout = (float*)(ws + WS_SD) + (u * 7 + seg) * 32;
            gla_unit<1, false>(lds, p, args, lane, w);
        }
    }
}
__device__ __forceinline__ void phase_2b(const Args& args, int tid) {
    unsigned char* ws = args.ws;
    const int gt = blockIdx.x * 512 + tid, NGT = gridDim.x * 512;
    for (int it = gt; it < 64 * 4096; it += NGT) {
        const int bh = it >> 12, e4 = it & 4095, kt = (e4 >> 6) & 7, fq = (e4 & 63) >> 4, k = 16 * kt + 4 * fq;
        f32x4 s = ((const f32x4*)hseg_slot(ws, bh, 0))[e4];
#pragma unroll
        for (int sl = 1; sl < 3; ++sl) { const f32x4 d = *(const f32x4*)((const float*)(ws + WS_HD) + (bh * 3 + sl) * 128 + k); f32x4* p = (f32x4*)hseg_slot(ws, bh, sl) + e4; s = d * s + *p; *p = s; }
    }
    for (int it = gt; it < 32 * 8192; it += NGT) {
        const int bg = it >> 13, e4 = it & 8191, wv = e4 >> 10;
        f32x4 s = ((const f32x4*)sseg_slot(ws, bg, 0))[e4];
#pragma unroll
        for (int sl = 1; sl < 7; ++sl) { const float d = ((const float*)(ws + WS_SD))[(bg * 7 + sl) * 32 + (wv >> 1)]; f32x4* p = (f32x4*)sseg_slot(ws, bg, sl) + e4; s = s * d + *p; *p = s; }
    }
}
__device__ __forceinline__ void phase_2c(LAS unsigned char* lds, const Args& args, int lane, int w) {
    unsigned char* ws = args.ws;
    for (int i = blockIdx.x; i < 256; i += gridDim.x) {
        for (int n0 = 0; n0 < (ENG_S ? 3 : 0); ++n0) {
            const int n = (i & 1) ? (n0 + 1) % 3 : n0;
            GlaP p; p.Dout = nullptr;
            if (n == 0) { const int u = i >> 3, seg = i & 7, b = u >> 2, g = (u >> 1) & 1;
                p.row0 = b * 2048 + seg * 256; p.ntok = 256; p.nch = 8; p.seq_t0 = seg * 256; p.head = g; p.half = u & 1; p.samp_b = -1;
                p.Sinit = seg ? sseg_slot(ws, u, seg - 1) : nullptr; p.init_lay = seg ? 2 : 0;
                p.Sout = (seg == 7) ? args.out + O_SSP + (size_t)(b * 16 + 8 * g + 4 * (u & 1)) * 8192 : nullptr; p.out_lay = (seg == 7) ? 1 : 0;
            } else { const int u = 2 * i + n - 1, b = u >> 2, g = (u >> 1) & 1;
                p.row0 = MP + 8 * b; p.ntok = 8; p.nch = 1; p.seq_t0 = 0; p.head = g; p.half = u & 1; p.samp_b = b;
                p.Sinit = args.in[3] + (size_t)(b * 16 + 8 * g + 4 * (u & 1)) * 8192; p.init_lay = 1; p.Sout = args.out + O_SSS + (size_t)(b * 16 + 8 * g + 4 * (u & 1)) * 8192; p.out_lay = 1; }
            gla_unit<1, true>(lds, p, args, lane, w);
        }
        for (int n0 = 0; n0 < (ENG_H ? 5 : 0); ++n0) {
            const int n = (i & 1) ? (n0 + 1) % 5 : n0;
            GlaP p; p.Dout = nullptr; p.half = 0;
            if (n == 0) { const int bh = i >> 2, seg = i & 3;
                p.row0 = (bh >> 3) * 2048 + seg * 512; p.ntok = 512; p.nch = 16; p.seq_t0 = seg * 512; p.head = bh & 7; p.samp_b = -1;
                p.Sinit = seg ? hseg_slot(ws, bh, seg - 1) : nullptr; p.init_lay = seg ? 2 : 0;
                p.Sout = (seg == 3) ? args.out + O_HGP + (size_t)bh * 16384 : nullptr; p.out_lay = (seg == 3) ? 1 : 0;
            } else { const int u = 4 * i + n - 1, b = u >> 3;
                p.row0 = MP + 8 * b; p.ntok = 8; p.nch = 1; p.seq_t0 = 0; p.head = u & 7; p.samp_b = b;
                p.Sinit = args.in[2] + (size_t)u * 16384; p.init_lay = 1; p.Sout = args.out + O_HGS + (size_t)u * 16384; p.out_lay = 1; }
            gla_unit<0, true>(lds, p, args, lane, w);
        }
    }
}
__device__ __forceinline__ void phase_2d(const Args& args, int tid) {
    unsigned char* ws = args.ws; bf16* QZ = (bf16*)(ws + WS_QZ); const float* SSQ = (const float*)(ws + WS_SSQ);
    for (int it = blockIdx.x * 512 + tid; it < M * 128; it += gridDim.x * 512) {
        const int row = it >> 7, c8 = (it & 127) * 8, g = c8 >> 9;
        const float rs = __builtin_amdgcn_rsqf(SSQ[row * 2 + g] * (1.0f / 512.0f) + EPS);
        u32x4* p = (u32x4*)(QZ + (size_t)row * 2048 + 1024 + c8); const u32x4 v = *p;
        const f32x4 g0 = *(const f32x4*)(args.in[14] + c8), g1 = *(const f32x4*)(args.in[14] + c8 + 4);
        u32x4 o; o.x = pkbf(lo16(v.x) * rs * g0[0], hi16(v.x) * rs * g0[1]); o.y = pkbf(lo16(v.y) * rs * g0[2], hi16(v.y) * rs * g0[3]);
        o.z = pkbf(lo16(v.z) * rs * g1[0], hi16(v.z) * rs * g1[1]); o.w = pkbf(lo16(v.w) * rs * g1[2], hi16(v.w) * rs * g1[3]);
        *p = o;
    }
}
__global__ void __launch_bounds__(NWAVES * 64, 2) mega(Args args) {
    extern __shared__ __attribute__((aligned(16))) unsigned char lds_raw[];
    LAS unsigned char* lds = (LAS unsigned char*)lds_raw;
    const int tid = threadIdx.x, lane = tid & 63, wave = __builtin_amdgcn_readfirstlane(tid >> 6);
    const int lo = args.ph_lo, hi = args.ph_hi, G = gridDim.x;
    unsigned char* ws = args.ws;
#define IN(k) (lo <= (k) && (k) < hi)
    volatile LAS unsigned* bst = (volatile LAS unsigned*)(lds + LDS_BYTES - 64);
    if (tid < 2) bst[tid] = 0u;
    __syncthreads();
    XcdBarrier bar = xcd_barrier_post((unsigned*)(ws + WS_BAR), bst);
#define SEAM(k) do { if (IN(k) && IN((k) + 1)) { xcd_barrier(bar); } } while (0)
    if (IN(0)) { p0_prologue(args, lds, tid, lane, wave); __syncthreads(); }
    SEAM(0);
    if (IN(1)) {
        pg8::Gemm g{(const bf16*)(ws + WS_XN), (const bf16*)(ws + WS_WIN), M, NIN, D, D}; pg8::StaticOrder S; S.init(M, NIN, G, (int)blockIdx.x);
        pg8::EpiIn E{(bf16*)(ws + WS_QZ), (bf16*)(ws + WS_F), (bf16*)(args.out) + (size_t)M * 1024, (bf16*)(args.out), (bf16*)(ws + WS_XBC), (const float*)(ws + WS_LB), args.out + O_CVP, args.out + O_CVS};
        pg8::gemm_phase<pg8::EpiIn, pg8::StaticOrder, true, true>(lds, g, S, E);
    }
    SEAM(1);
    if (IN(2)) { phase_2a(lds, args, lane, wave);
        if (!ENG_S) { for (size_t idx = (size_t)blockIdx.x * 512 + tid; idx < (size_t)M * 1536; idx += (size_t)G * 512) conv_act_elem((const bf16*)(ws + WS_XBC), args.in[4], args.in[9], args.in[10], (bf16*)(ws + 204 * MiB), idx); } }
    SEAM(2);
    if (IN(3)) { phase_2b(args, tid); }
    SEAM(3);
    if (IN(4)) { phase_2c(lds, args, lane, wave);
        LAS float* red = (LAS float*)lds;
        if (!ENG_H) { __syncthreads();
            for (int grp = blockIdx.x; grp < 16 + 256; grp += G)
                simple_hgrn(red + 2 * (tid >> 7), grp * 4 + (tid >> 7), tid & 127, (bf16*)(ws + WS_QZ), (const unsigned short*)(ws + WS_F), (const bf16*)(args.out) + (size_t)M * 1024, (const bf16*)(args.out), args.in[2], args.in[8], args.out + O_HGP, args.out + O_HGS);
            __syncthreads(); }
        if (!ENG_S) { __syncthreads();
            for (int u = blockIdx.x; u < 16 + 256; u += G)
                simple_ssd(red + 16, u, (bf16*)(ws + WS_QZ), (const bf16*)(ws + 204 * MiB), (const float*)(ws + WS_DT), args.in[3], args.in[12], args.in[13], args.in[14], args.out + O_SSP, args.out + O_SSS);
            __syncthreads(); }
    }
    SEAM(4);
    if (IN(5) && ENG_S) { phase_2d(args, tid); }
    SEAM(5);
    if (IN(6)) {
        pg8::Gemm g{(const bf16*)(ws + WS_QZ), (const bf16*)(ws + WS_WOUT), M, D, DMIX, DMIX}; pg8::StaticOrder S; S.init(M, D, G, (int)blockIdx.x);
        pg8::EpiOut E{args.in[0], args.in[1], args.out + O_Y, (bf16*)(ws + WS_XG), args.in[16], (float*)(ws + WS_RSS1)};
        pg8::gemm_phase<pg8::EpiOut, pg8::StaticOrder, true, true>(lds, g, S, E);
    }
    SEAM(6);
    if (IN(7)) {
        pg8::Gemm g{(const bf16*)(ws + WS_XG), (const bf16*)(ws + WS_WUP), M, FF, D, D}; pg8::StaticOrder S; S.init(M, FF, G, (int)blockIdx.x);
        pg8::EpiUp E{(bf16*)(ws + WS_U), (const float*)(ws + WS_RSS1)};
        pg8::gemm_phase<pg8::EpiUp, pg8::StaticOrder, true, true>(lds, g, S, E);
    }
    SEAM(7);
    if (IN(8)) {
        {
            pg8::Gemm g{(const bf16*)(ws + WS_U), (const bf16*)(ws + WS_WDN), M, D, FF / 8, FF}; pg8::SplitOrder S{G, (int)blockIdx.x};
            pg8::EpiDownSplit E{(float*)(ws + WS_PART)};
            pg8::gemm_phase<pg8::EpiDownSplit, pg8::SplitOrder, true, true>(lds, g, S, E);
        }
        pg8::Gemm g{(const bf16*)(ws + WS_U), (const bf16*)(ws + WS_WDN), MP, D, FF, FF}; pg8::StaticOrder S; S.init(MP, D, G, (int)blockIdx.x);
        pg8::EpiDown E{args.out + O_Y};
        pg8::gemm_phase<pg8::EpiDown, pg8::StaticOrder, true, true>(lds, g, S, E);
    }
    SEAM(8);
    if (IN(9)) p6_final(args, lane, wave);
#undef IN
#undef SEAM
}
extern "C" void kernel_launch(void* const* d_in, const int* in_sizes, int n_in, void* d_out, int out_size, void* d_ws, size_t ws_size, hipStream_t stream) {
    static int grid = 0;
    if (grid == 0) {
        int dev = 0, cus = 0, per_cu = 0;
        (void)hipGetDevice(&dev); (void)hipDeviceGetAttribute(&cus, hipDeviceAttributeMultiprocessorCount, dev);
        if (hipFuncSetAttribute((const void*)mega, hipFuncAttributeMaxDynamicSharedMemorySize, LDS_BYTES) != hipSuccess) { fprintf(stderr, "hipFuncSetAttribute failed\n"); grid = -1; return; }
        if (n_in != 20 || out_size != (int)O_END || ws_size < WS_END) { fprintf(stderr, "kernel_launch: unexpected sizes n_in %d out %d ws %zu\n", n_in, out_size, ws_size); grid = -1; return; }
        if (hipOccupancyMaxActiveBlocksPerMultiprocessor(&per_cu, (const void*)mega, 512, LDS_BYTES) != hipSuccess || per_cu < 1) { fprintf(stderr, "occupancy query failed (%d)\n", per_cu); grid = -1; return; }
        grid = (cus > 0 ? cus : 256) * 1;
    }
    if (grid < 0) return;
    Args a{};
    for (int i = 0; i < 20; ++i) a.in[i] = (const float*)d_in[i];
    a.out = (float*)d_out; a.ws = (unsigned char*)d_ws; a.ph_lo = 0; a.ph_hi = 10;
    if (hipMemsetAsync((char*)d_ws + WS_BAR, 0, 16384, stream) != hipSuccess) { fprintf(stderr, "memset failed\n"); return; }
    void* kargs[] = {&a};
    hipError_t e = hipLaunchCooperativeKernel((const void*)mega, dim3(grid), dim3(512), kargs, LDS_BYTES, stream);
    if (e != hipSuccess) fprintf(stderr, "cooperative launch failed: %s (grid %d)\n", hipGetErrorString(e), grid);
}
```

```cpp
#define ENG_H 1
#define ENG_S 1
#include <hip/hip_runtime.h>
#include <cstdio>
#include <cstdint>
namespace pg8 {
#define PG8_LAS __attribute__((address_space(3)))
typedef unsigned short bf16_t;
typedef short bf16x8 __attribute__((ext_vector_type(8)));
typedef float f32x4 __attribute__((ext_vector_type(4)));
typedef unsigned u32x4 __attribute__((ext_vector_type(4)));
constexpr int BM = 256, BK = 64, HALF = 128, HTB = HALF * BK * 2  , STAGE_BYTES = 8 * HTB, NXCD = 8, WGM = 8;

__host__ __device__ __forceinline__ int lds_byte(int r, int c) { const int st = (r >> 4) * 2 + (c >> 5), rr = r & 15, cc = c & 31, ob = rr * 64 + cc * 2; return st * 1024 + (ob ^ (((ob >> 9) & 1) << 5)); }
__host__ __device__ __forceinline__ void stage_rc(int b, int& R, int& C) { const int st = b / 1024, sb = b % 1024, swz = sb ^ (((sb >> 9) & 1) << 5); R = (st >> 1) * 16 + swz / 64; C = (st & 1) * 32 + (swz % 64) / 2; }
__host__ __device__ __forceinline__ int perm32(int rho) { const int n = rho >> 4, i = rho & 15; return 8 * (i >> 2) + 4 * n + (i & 3); }

struct Unit { int pm, pn, ks; };
struct Gemm { const bf16_t* A; const bf16_t* Bt; int M, N, K, ld; };

struct StaticOrder {
    int nM, nN, nwg, G, c;
    __host__ __device__ void init(int M, int N, int G_, int c_) { nM = M / BM; nN = N / BM; nwg = nM * nN; G = G_; c = c_; }
    __host__ __device__ bool next(int i, Unit& u) const {
        const long L = (long)i * G + c; if (L >= nwg) return false;
        int wgid = (int)L; { const int q = nwg / NXCD, r = nwg % NXCD, xcd = wgid % NXCD, off = wgid / NXCD; wgid = (xcd < r ? xcd * (q + 1) : r * (q + 1) + (xcd - r) * q) + off; }
        const int nig = WGM * nN, gid = wgid / nig, fm = gid * WGM, gsz = (nM - fm) < WGM ? (nM - fm) : WGM;
        u.pm = fm + ((wgid % nig) % gsz); u.pn = (wgid % nig) / gsz; u.ks = 0; return true;
    }
    __device__ __forceinline__ void a_ready(const Unit&) const {}
    __device__ __forceinline__ void done(const Unit&) const {}
};

__device__ __forceinline__ unsigned cvt_pk_bf16(float lo, float hi) { unsigned r; asm volatile("v_cvt_pk_bf16_f32 %0, %1, %2" : "=v"(r) : "v"(lo), "v"(hi)); return r; }
__device__ __forceinline__ unsigned pk_f16(float lo, float hi) { _Float16 a = (_Float16)lo, b = (_Float16)hi; return (unsigned)__builtin_bit_cast(unsigned short, a) | ((unsigned)__builtin_bit_cast(unsigned short, b) << 16); }
__device__ __forceinline__ float silu_f(float x) { return x * __builtin_amdgcn_rcpf(1.0f + __expf(-x)); }
typedef unsigned u32x2 __attribute__((ext_vector_type(2)));
constexpr int MP_ROWS = 16384;

struct EpiIn {
    static constexpr bool PERM = true, AFTER_DRAIN = false;
    bf16_t* QZ; bf16_t* F; bf16_t* I; bf16_t* G; bf16_t* XBC; const float* LB; float* cvp; float* cvs;
    __device__ __forceinline__ void operator()(const f32x4 (&acc)[2][2][4][2], const Unit& u, int wr, int wc, int fr, int fq) const {
        const int pn = u.pn, row0 = u.pm * BM + wr * 64 + fr, cl = wc * 32 + 8 * fq;
        int reg, ldc, colt; bf16_t* base;
        if (pn < 4)       { base = QZ;        ldc = 2048; colt = pn * 256;        reg = 0; }
        else if (pn < 8)  { base = F;         ldc = 1024; colt = (pn - 4) * 256;  reg = 1; }
        else if (pn < 12) { base = I;         ldc = 1024; colt = (pn - 8) * 256;  reg = 0; }
        else if (pn < 16) { base = G;         ldc = 1024; colt = (pn - 12) * 256; reg = 2; }
        else if (pn < 20) { base = QZ + 1024; ldc = 2048; colt = (pn - 16) * 256; reg = 2; }
        else              { base = XBC;       ldc = 1536; colt = (pn - 20) * 256; reg = 3; }
        f32x4 lb[2][2];
        if (reg == 1) {
#pragma unroll
            for (int bj = 0; bj < 2; ++bj)
#pragma unroll
                for (int n = 0; n < 2; ++n) lb[bj][n] = *(const f32x4*)(LB + colt + cl + bj * HALF + 4 * n);
        }
#pragma unroll
        for (int ai = 0; ai < 2; ++ai)
#pragma unroll
            for (int m = 0; m < 4; ++m) {
                const int row = row0 + ai * HALF + m * 16;
                bf16_t* rowp = base + (size_t)row * ldc + colt + cl;
                float* cdst = nullptr;
                if (reg == 3) {
                    if (row < MP_ROWS) { const int t = row & 2047; if (t >= 2045) cdst = cvp + (size_t)((row >> 11) * 3 + (t - 2045)) * 1536 + colt + cl; }
                    else { const int r = row - MP_ROWS, t = r & 7; if (t >= 5) cdst = cvs + (size_t)((r >> 3) * 3 + (t - 5)) * 1536 + colt + cl; }
                }
#pragma unroll
                for (int bj = 0; bj < 2; ++bj) {
                    f32x4 v0 = acc[ai][bj][m][0], v1 = acc[ai][bj][m][1];
                    u32x4 w;
                    if (reg == 1) {
                        f32x4 l0 = lb[bj][0], l1 = lb[bj][1];
#pragma unroll
                        for (int e = 0; e < 4; ++e) {
                            float s0 = __builtin_amdgcn_rcpf(1.0f + __expf(-v0[e])), s1 = __builtin_amdgcn_rcpf(1.0f + __expf(-v1[e]));
                            v0[e] = __logf(l0[e] + (1.0f - l0[e]) * s0); v1[e] = __logf(l1[e] + (1.0f - l1[e]) * s1);
                        }
                        w.x = pk_f16(v0[0], v0[1]); w.y = pk_f16(v0[2], v0[3]); w.z = pk_f16(v1[0], v1[1]); w.w = pk_f16(v1[2], v1[3]);
                    } else {
                        if (reg == 2) {
#pragma unroll
                            for (int e = 0; e < 4; ++e) { v0[e] = silu_f(v0[e]); v1[e] = silu_f(v1[e]); }
                        }
                        if (reg == 3 && cdst) { *(f32x4*)(cdst + bj * HALF) = v0; *(f32x4*)(cdst + bj * HALF + 4) = v1; }
                        w.x = cvt_pk_bf16(v0[0], v0[1]); w.y = cvt_pk_bf16(v0[2], v0[3]); w.z = cvt_pk_bf16(v1[0], v1[1]); w.w = cvt_pk_bf16(v1[2], v1[3]);
                    }
                    *(u32x4*)(rowp + bj * HALF) = w;
                }
            }
    }
};

struct EpiOut {
    static constexpr bool PERM = false, AFTER_DRAIN = false;
    const float* xp; const float* xs; float* X1; bf16_t* XG; const float* ln2; float* rowss;
    __device__ __forceinline__ void operator()(const f32x4 (&acc)[2][2][4][2], const Unit& u, int wr, int wc, int fr, int fq) const {
        const int row0 = u.pm * BM + wr * 64 + fr, col0 = u.pn * BM + wc * 32 + 4 * fq;
        f32x4 gn[2][2];
#pragma unroll
        for (int bj = 0; bj < 2; ++bj)
#pragma unroll
            for (int n = 0; n < 2; ++n) gn[bj][n] = *(const f32x4*)(ln2 + col0 + bj * HALF + n * 16);
#pragma unroll
        for (int ai = 0; ai < 2; ++ai)
#pragma unroll
            for (int m = 0; m < 4; ++m) {
                const int row = row0 + ai * HALF + m * 16;
                const float* xin = (row < MP_ROWS) ? xp + (size_t)row * 1024 : xs + (size_t)(row - MP_ROWS) * 1024;
                float ss = 0.f;
#pragma unroll
                for (int bj = 0; bj < 2; ++bj)
#pragma unroll
                    for (int n = 0; n < 2; ++n) {
                        const int col = col0 + bj * HALF + n * 16;
                        const f32x4 v = *(const f32x4*)(xin + col) + acc[ai][bj][m][n];
                        *(f32x4*)(X1 + (size_t)row * 1024 + col) = v;
                        ss += (v[0] * v[0] + v[1] * v[1]) + (v[2] * v[2] + v[3] * v[3]);
                        const f32x4 g = v * gn[bj][n]; u32x2 w; w.x = cvt_pk_bf16(g[0], g[1]); w.y = cvt_pk_bf16(g[2], g[3]);
                        *(u32x2*)(XG + (size_t)row * 1024 + col) = w;
                    }
                ss += __shfl_xor(ss, 16); ss += __shfl_xor(ss, 32);
                if (fq == 0) unsafeAtomicAdd(rowss + row, ss);
            }
    }
};

struct EpiUp {
    static constexpr bool PERM = true, AFTER_DRAIN = false;
    bf16_t* U; const float* rowss;
    __device__ __forceinline__ void operator()(const f32x4 (&acc)[2][2][4][2], const Unit& u, int wr, int wc, int fr, int fq) const {
        const int row0 = u.pm * BM + wr * 64 + fr, col0 = u.pn * BM + wc * 32 + 8 * fq;
#pragma unroll
        for (int ai = 0; ai < 2; ++ai)
#pragma unroll
            for (int m = 0; m < 4; ++m) {
                const int row = row0 + ai * HALF + m * 16;
                const float rs = __builtin_amdgcn_rsqf(rowss[row] * (1.0f / 1024.0f) + 1e-5f);
                bf16_t* rowp = U + (size_t)row * 4096 + col0;
#pragma unroll
                for (int bj = 0; bj < 2; ++bj) {
                    f32x4 v0 = acc[ai][bj][m][0] * rs, v1 = acc[ai][bj][m][1] * rs;
#pragma unroll
                    for (int e = 0; e < 4; ++e) { float a = fmaxf(v0[e], 0.f), b = fmaxf(v1[e], 0.f); v0[e] = a * a; v1[e] = b * b; }
                    u32x4 w; w.x = cvt_pk_bf16(v0[0], v0[1]); w.y = cvt_pk_bf16(v0[2], v0[3]); w.z = cvt_pk_bf16(v1[0], v1[1]); w.w = cvt_pk_bf16(v1[2], v1[3]);
                    *(u32x4*)(rowp + bj * HALF) = w;
                }
            }
    }
};

struct EpiDown {
    static constexpr bool PERM = false, AFTER_DRAIN = false;
    float* X1;
    __device__ __forceinline__ void operator()(const f32x4 (&acc)[2][2][4][2], const Unit& u, int wr, int wc, int fr, int fq) const {
        const int row0 = u.pm * BM + wr * 64 + fr, col0 = u.pn * BM + wc * 32 + 4 * fq;
#pragma unroll
        for (int ai = 0; ai < 2; ++ai)
#pragma unroll
            for (int m = 0; m < 4; ++m) {
                const int row = row0 + ai * HALF + m * 16;
#pragma unroll
                for (int bj = 0; bj < 2; ++bj)
#pragma unroll
                    for (int n = 0; n < 2; ++n) { float* p = X1 + (size_t)row * 1024 + col0 + bj * HALF + n * 16; *(f32x4*)p = *(const f32x4*)p + acc[ai][bj][m][n]; }
            }
    }
};
struct EpiDownSplit {
    static constexpr bool PERM = false, AFTER_DRAIN = false;
    float* PART;
    __device__ __forceinline__ void operator()(const f32x4 (&acc)[2][2][4][2], const Unit& u, int wr, int wc, int fr, int fq) const {
        const int row0 = (u.pm - 64) * BM + wr * 64 + fr, col0 = u.pn * BM + wc * 32 + 4 * fq;
        float* base = PART + (size_t)u.ks * 1024 * 1024;
#pragma unroll
        for (int ai = 0; ai < 2; ++ai)
#pragma unroll
            for (int m = 0; m < 4; ++m) {
                const int row = row0 + ai * HALF + m * 16;
#pragma unroll
                for (int bj = 0; bj < 2; ++bj)
#pragma unroll
                    for (int n = 0; n < 2; ++n) *(f32x4*)(base + (size_t)row * 1024 + col0 + bj * HALF + n * 16) = acc[ai][bj][m][n];
            }
    }
};
struct SplitOrder {
    int G, c;
    __device__ bool next(int i, Unit& u) const { const int t = i * G + c; if (t >= 64) return false; const int tile = t >> 2; u.pm = 64 + (tile >> 2); u.pn = tile & 3; u.ks = t & 3; return true; }
    __device__ __forceinline__ void a_ready(const Unit&) const {}
    __device__ __forceinline__ void done(const Unit&) const {}
};

template <class Epi, class Sched, bool ALIGN_EPI = false, bool SP2 = false>
__device__ __forceinline__ void gemm_phase(PG8_LAS unsigned char* lds, const Gemm g, const Sched& S, const Epi& E) {
    int tid_ = threadIdx.x; asm volatile("" : "+v"(tid_));
    const int tid = tid_, wid = __builtin_amdgcn_readfirstlane(tid >> 6), lane = tid & 63, wr = wid >> 2, wc = wid & 3, fr = lane & 15, fq = lane >> 4;
    const int K = g.ld, nt = g.K / BK;
    unsigned voffA[2], voffB[2];
#pragma unroll
    for (int i = 0; i < 2; ++i) { int R, C; stage_rc(tid * 16 + i * 8192, R, C); const int Rb = Epi::PERM ? ((R & ~31) + perm32(R & 31)) : R;
        voffA[i] = (unsigned)(R * K + C) * 2u; voffB[i] = (unsigned)(Rb * K + C) * 2u; }
    const size_t kstep = (size_t)(BK * 2);
    const size_t hstep = (size_t)HALF * K * 2;
    const size_t tstep = 2 * hstep;
    const unsigned ldsw = (unsigned)wid * 1024u;
    const int aoff = lds_byte(wr * 64 + fr, fq * 8), boff = lds_byte(wc * 32 + fr, fq * 8);
#define PG8_SA(b, h) (((b) * 2 + (h)) * HTB)
#define PG8_SB(b, h) ((4 + (b) * 2 + (h)) * HTB)
#define PG8_STAGE(bufoff, gbase, voff) do { _Pragma("unroll") for (int _i = 0; _i < 2; ++_i) \
        __builtin_amdgcn_global_load_lds((const unsigned*)((const char*)(gbase) + (voff)[_i]), (PG8_LAS unsigned*)(lds + (bufoff) + ldsw + _i * 8192), 16, 0, 0); } while (0)
#define PG8_LDA(dst, b, h) do { _Pragma("unroll") for (int m = 0; m < 4; ++m) _Pragma("unroll") for (int k = 0; k < 2; ++k) dst[m][k] = *(const PG8_LAS bf16x8*)(lds + PG8_SA(b, h) + aoff + m * 2048 + k * 1024); } while (0)
#define PG8_LDB(dst, b, h) do { _Pragma("unroll") for (int n = 0; n < 2; ++n) _Pragma("unroll") for (int k = 0; k < 2; ++k) dst[n][k] = *(const PG8_LAS bf16x8*)(lds + PG8_SB(b, h) + boff + n * 2048 + k * 1024); } while (0)
#define PG8_MMA(ai, bj, At, Bt) do { __builtin_amdgcn_s_setprio(1); _Pragma("unroll") for (int m = 0; m < 4; ++m) _Pragma("unroll") for (int n = 0; n < 2; ++n) _Pragma("unroll") for (int k = 0; k < 2; ++k) \
        acc[ai][bj][m][n] = __builtin_amdgcn_mfma_f32_16x16x32_bf16(Bt[n][k], At[m][k], acc[ai][bj][m][n], 0, 0, 0); __builtin_amdgcn_s_setprio(0); } while (0)
#define PG8_WAIT_V(n) asm volatile("s_waitcnt vmcnt(" #n ")" ::: "memory")
#define PG8_WAIT_L(n) asm volatile("s_waitcnt lgkmcnt(" #n ")" ::: "memory")
#define PG8_BAR __builtin_amdgcn_s_barrier()
#define PG8_SCHED __builtin_amdgcn_sched_barrier(0)
    Unit cur, nxt; int ui = 0;
    if (!S.next(0, cur)) return;
    f32x4 acc[2][2][4][2];
#pragma unroll
    for (int a = 0; a < 2; ++a)
#pragma unroll
        for (int b = 0; b < 2; ++b)
#pragma unroll
            for (int m = 0; m < 4; ++m)
#pragma unroll
                for (int n = 0; n < 2; ++n) acc[a][b][m][n] = (f32x4){0.f, 0.f, 0.f, 0.f};
    bf16x8 At[4][2], B0[2][2], B1[2][2];
    const size_t sstep = (size_t)g.K * 2;
    const char* cA = (const char*)g.A + (size_t)cur.pm * tstep + (size_t)cur.ks * sstep; const char* cB = (const char*)g.Bt + (size_t)cur.pn * tstep + (size_t)cur.ks * sstep;
    S.a_ready(cur);
    if constexpr (SP2) {
        PG8_STAGE(PG8_SB(0, 0), cB, voffB); PG8_STAGE(PG8_SB(0, 1), cB + hstep, voffB); PG8_STAGE(PG8_SA(0, 0), cA, voffA); PG8_STAGE(PG8_SA(0, 1), cA + hstep, voffA);
        if (wr == 1) PG8_BAR;
        PG8_WAIT_V(2); PG8_BAR;
        PG8_STAGE(PG8_SB(1, 0), cB + kstep, voffB); PG8_STAGE(PG8_SA(1, 0), cA + kstep, voffA); PG8_STAGE(PG8_SB(1, 1), cB + hstep + kstep, voffB);
        PG8_WAIT_V(6); PG8_BAR;
    } else {
        PG8_STAGE(PG8_SB(0, 0), cB, voffB); PG8_STAGE(PG8_SA(0, 0), cA, voffA); PG8_STAGE(PG8_SB(0, 1), cB + hstep, voffB); PG8_STAGE(PG8_SA(0, 1), cA + hstep, voffA);
        if (wr == 1) PG8_BAR;
        PG8_WAIT_V(4); PG8_BAR;
        PG8_STAGE(PG8_SB(1, 0), cB + kstep, voffB); PG8_STAGE(PG8_SA(1, 0), cA + kstep, voffA); PG8_STAGE(PG8_SB(1, 1), cB + hstep + kstep, voffB);
        PG8_WAIT_V(6); PG8_BAR;
    }
    for (;;) {
        const bool has_next = S.next(ui + 1, nxt);
        const char* nA = has_next ? (const char*)g.A + (size_t)nxt.pm * tstep + (size_t)nxt.ks * sstep : cA; const char* nB = has_next ? (const char*)g.Bt + (size_t)nxt.pn * tstep + (size_t)nxt.ks * sstep : cB;
        for (int t = 0; t < nt; t += 2) {
            const bool last = (t == nt - 2);
            const char* a1 = cA + (size_t)(t + 1) * kstep;
            const char* a2 = last ? nA : cA + (size_t)(t + 2) * kstep; const char* b2 = last ? nB : cB + (size_t)(t + 2) * kstep;
            const char* a3 = a2 + kstep; const char* b3 = b2 + kstep;
            if (last && has_next) S.a_ready(nxt);
            if constexpr (SP2) {
            PG8_LDB(B0, 0, 0); PG8_LDB(B1, 0, 1); PG8_SCHED; PG8_LDA(At, 0, 0); PG8_STAGE(PG8_SA(1, 1), a1 + hstep, voffA);
            PG8_WAIT_V(8); PG8_WAIT_L(0); PG8_BAR; PG8_MMA(0, 0, At, B0); PG8_MMA(0, 1, At, B1); PG8_BAR; PG8_SCHED;
            PG8_LDA(At, 0, 1); PG8_STAGE(PG8_SB(0, 0), b2, voffB); PG8_STAGE(PG8_SB(0, 1), b2 + hstep, voffB); PG8_STAGE(PG8_SA(0, 0), a2, voffA);
            PG8_WAIT_V(8); PG8_WAIT_L(0); PG8_BAR; PG8_MMA(1, 0, At, B0); PG8_MMA(1, 1, At, B1); PG8_BAR; PG8_SCHED;
            PG8_LDB(B0, 1, 0); PG8_LDB(B1, 1, 1); PG8_SCHED; PG8_LDA(At, 1, 0); PG8_STAGE(PG8_SA(0, 1), a2 + hstep, voffA);
            PG8_WAIT_V(8); PG8_WAIT_L(0); PG8_BAR; PG8_MMA(0, 0, At, B0); PG8_MMA(0, 1, At, B1); PG8_BAR; PG8_SCHED;
            PG8_LDA(At, 1, 1); PG8_STAGE(PG8_SB(1, 0), b3, voffB); PG8_STAGE(PG8_SB(1, 1), b3 + hstep, voffB); PG8_STAGE(PG8_SA(1, 0), a3, voffA);
            PG8_WAIT_V(8); PG8_WAIT_L(0); PG8_BAR; PG8_MMA(1, 0, At, B0); PG8_MMA(1, 1, At, B1); PG8_BAR; PG8_SCHED;
            } else {
            PG8_LDB(B0, 0, 0); PG8_SCHED; PG8_LDA(At, 0, 0); PG8_STAGE(PG8_SA(1, 1), a1 + hstep, voffA);
            PG8_WAIT_L(8); PG8_BAR; PG8_WAIT_L(0); PG8_MMA(0, 0, At, B0); PG8_BAR; PG8_SCHED;
            PG8_LDB(B1, 0, 1); PG8_STAGE(PG8_SB(0, 0), b2, voffB);
            PG8_BAR; PG8_WAIT_L(0); PG8_MMA(0, 1, At, B1); PG8_BAR;
            PG8_LDA(At, 0, 1); PG8_STAGE(PG8_SA(0, 0), a2, voffA);
            PG8_BAR; PG8_WAIT_L(0); PG8_MMA(1, 0, At, B0); PG8_BAR; PG8_SCHED;
            PG8_STAGE(PG8_SB(0, 1), b2 + hstep, voffB);
            PG8_WAIT_V(6); PG8_BAR; PG8_MMA(1, 1, At, B1); PG8_BAR;
            PG8_LDB(B0, 1, 0); PG8_SCHED; PG8_LDA(At, 1, 0); PG8_STAGE(PG8_SA(0, 1), a2 + hstep, voffA);
            PG8_WAIT_L(8); PG8_BAR; PG8_WAIT_L(0); PG8_MMA(0, 0, At, B0); PG8_BAR; PG8_SCHED;
            PG8_LDB(B1, 1, 1); PG8_STAGE(PG8_SB(1, 0), b3, voffB);
            PG8_BAR; PG8_WAIT_L(0); PG8_MMA(0, 1, At, B1); PG8_BAR;
            PG8_LDA(At, 1, 1); PG8_STAGE(PG8_SA(1, 0), a3, voffA);
            PG8_BAR; PG8_WAIT_L(0); PG8_MMA(1, 0, At, B0); PG8_BAR; PG8_SCHED;
            PG8_STAGE(PG8_SB(1, 1), b3 + hstep, voffB);
            PG8_WAIT_V(6); PG8_BAR; PG8_MMA(1, 1, At, B1); PG8_BAR;
            }
        }
        if constexpr (ALIGN_EPI) { if (wr == 0) PG8_BAR; }
        if constexpr (!Epi::AFTER_DRAIN) { E(acc, cur, wr, wc, fr, fq); S.done(cur); }
        if (!has_next) break;
#pragma unroll
        for (int a = 0; a < 2; ++a)
#pragma unroll
            for (int b = 0; b < 2; ++b)
#pragma unroll
                for (int m = 0; m < 4; ++m)
#pragma unroll
                    for (int n = 0; n < 2; ++n) acc[a][b][m][n] = (f32x4){0.f, 0.f, 0.f, 0.f};
        cur = nxt; cA = nA; cB = nB; ++ui;
        if constexpr (ALIGN_EPI) { if (wr == 1) PG8_BAR; }
    }
    PG8_WAIT_V(0);
    if constexpr (!ALIGN_EPI) { if (wr == 0) PG8_BAR; }
    PG8_BAR;
    if constexpr (Epi::AFTER_DRAIN) { E.fused(acc, cur, wr, wc, fr, fq, lds, wid, lane); S.done(cur); }
#undef PG8_SA
#undef PG8_SB
#undef PG8_STAGE
#undef PG8_LDA
#undef PG8_LDB
#undef PG8_MMA
#undef PG8_WAIT_V
#undef PG8_WAIT_L
#undef PG8_BAR
#undef PG8_SCHED
}
}
#include <hip/hip_cooperative_groups.h>
namespace cg = cooperative_groups;
#define LAS __attribute__((address_space(3)))
typedef unsigned short bf16;
typedef pg8::f32x4 f32x4;
typedef pg8::u32x4 u32x4;
typedef pg8::u32x2 u32x2;
typedef float f32x2 __attribute__((ext_vector_type(2)));
typedef pg8::bf16x8 bf16x8;
using pg8::cvt_pk_bf16;
using pg8::silu_f;
constexpr int NWAVES = 8;
constexpr int M = 17408, MP = 16384, MS = 1024, D = 1024, NIN = 6656, LDWIN = 6672, DMIX = 2048, FF = 4096;
constexpr float EPS = 1e-5f;
constexpr size_t MiB = 1u << 20;
constexpr size_t WS_PART = 236 * MiB;
constexpr size_t WS_HD = 1572864, WS_SD = 1835008, WS_SSQ = 1884160;
constexpr size_t WS_DT = 0, WS_RSS1 = 1114112, WS_RSS2 = WS_RSS1 + 69632, WS_LB = WS_RSS2 + 69632;
constexpr size_t WS_WIN = 2 * MiB, WS_WOUT = 15 * MiB, WS_WUP = 19 * MiB, WS_WDN = 27 * MiB, WS_F = 35 * MiB, WS_XG = 35 * MiB, WS_QZ = 69 * MiB, WS_XBC = 137 * MiB;
constexpr size_t WS_HSEG = 188 * MiB, WS_SSEG = 204 * MiB, WS_XN = 188 * MiB, WS_U = 69 * MiB, WS_XBA = 188 * MiB, WS_END = 252 * MiB;
constexpr size_t O_Y = 0, O_HGP = 17825792, O_HGS = 18874368, O_SSP = 35651584, O_SSS = 36700160, O_CVP = 53477376, O_CVS = 53514240, O_END = 54104064;
constexpr int LDS_BYTES = 147456;

__device__ __forceinline__ float wave_sum(float v) {
#pragma unroll
    for (int o = 1; o < 64; o <<= 1) v += __shfl_xor(v, o);
    return v;
}
__device__ __forceinline__ float bf2f(bf16 b) { return __uint_as_float((unsigned)b << 16); }
__device__ __forceinline__ float h2f(unsigned short h) { return (float)__builtin_bit_cast(_Float16, h); }

#define XB_TMO      128
#define XB_XCNT(j)  (256  + 64 * (j))
#define XB_XSUB(j)  (1280 + 64 * (j))
#define XB_XGEN(j)  (2304 + 64 * (j))
#define XB_TOP      3328
#define XB_TOPGEN   3392
#define XCD_BAR_WORDS 3456
#define XB_SPIN_CAP (1u << 18)

__device__ __forceinline__ unsigned xb_ld(unsigned* p)              { return __hip_atomic_load(p, __ATOMIC_RELAXED, __HIP_MEMORY_SCOPE_AGENT); }
__device__ __forceinline__ unsigned xb_add(unsigned* p, unsigned v) { return __hip_atomic_fetch_add(p, v, __ATOMIC_RELAXED, __HIP_MEMORY_SCOPE_AGENT); }
__device__ __forceinline__ unsigned xb_xcc_id() { return (unsigned)__builtin_amdgcn_s_getreg((3 << 11) | 20) & 0xFu; }
#define XB_SPIN(cond, bar) do { unsigned _sp = 0; while (cond) { __builtin_amdgcn_s_sleep(1); \
    if ((++_sp & 255u) == 0u) { if (xb_ld(&(bar)[XB_TMO])) break; if (_sp > XB_SPIN_CAP) { atomicAdd(&(bar)[XB_TMO], 1u); break; } } } } while (0)

struct XcdBarrier {
    unsigned* bar; unsigned x;
    volatile LAS unsigned* st;
};

__device__ __forceinline__ XcdBarrier xcd_barrier_post(unsigned* bar, volatile LAS unsigned* st) {
    XcdBarrier b; b.bar = bar; b.x = xb_xcc_id(); b.st = st;
    if (threadIdx.x == 0) (void)xb_add(&bar[XB_XCNT(b.x)], 1u);
    return b;
}
__device__ __forceinline__ void xcd_barrier_complete(unsigned* bar, unsigned x, unsigned& nloc, unsigned& nx) {
    const unsigned G = gridDim.x * gridDim.y * gridDim.z;
    unsigned sum, cnt, mine, sp = 0u;
    for (;;) {
        sum = 0u; cnt = 0u; mine = 0u;
#pragma unroll
        for (unsigned j = 0; j < 16; ++j) { const unsigned c = xb_ld(&bar[XB_XCNT(j)]); sum += c; cnt += (c > 0u) ? 1u : 0u; mine = (j == x) ? c : mine; }
        if (sum == G) break;
        __builtin_amdgcn_s_sleep(1);
        if ((++sp & 255u) == 0u) { if (xb_ld(&bar[XB_TMO])) break; if (sp > XB_SPIN_CAP) { atomicAdd(&bar[XB_TMO], 1u); break; } }
    }
    nloc = mine > 0u ? mine : 1u; nx = cnt > 0u ? cnt : 1u;
}

__device__ __forceinline__ void xcd_barrier(const XcdBarrier& b) {
    asm volatile("s_waitcnt vmcnt(0)" ::: "memory");
    __syncthreads();
    if (threadIdx.x == 0) {
        unsigned* bar = b.bar;
        __builtin_amdgcn_s_waitcnt(0);
        unsigned nloc = b.st[0], nx = b.st[1];
        if (nloc == 0u) { xcd_barrier_complete(bar, b.x, nloc, nx); b.st[0] = nloc; b.st[1] = nx; }
        const unsigned old = xb_add(&bar[XB_XSUB(b.x)], 1u);
        const unsigned gen = old / nloc;
        if (old + 1u == (gen + 1u) * nloc) {
            __builtin_amdgcn_fence(__ATOMIC_RELEASE, "agent");
            asm volatile("s_waitcnt vmcnt(0)" ::: "memory");
            const unsigned og = xb_add(&bar[XB_TOP], 1u);
            const unsigned tg = og / nx;
            if (og + 1u == (tg + 1u) * nx) xb_add(&bar[XB_TOPGEN], 1u);
            else XB_SPIN(xb_ld(&bar[XB_TOPGEN]) == tg, bar);
            __builtin_amdgcn_fence(__ATOMIC_ACQUIRE, "agent");
            xb_add(&bar[XB_XGEN(b.x)], 1u);
            asm volatile("s_waitcnt vmcnt(0)" ::: "memory");
        } else {
            XB_SPIN(xb_ld(&bar[XB_XGEN(b.x)]) == gen, bar);
            __builtin_amdgcn_fence(__ATOMIC_ACQUIRE, "agent");
            asm volatile("s_waitcnt vmcnt(0)" ::: "memory");
        }
    }
    __syncthreads();
}

constexpr size_t WS_BAR = 1310720;
struct Args { const float* in[20]; float* out; unsigned char* ws; int ph_lo, ph_hi; };

__device__ __forceinline__ void p0_transpose_item(const float* W, int ldw, int K, int nblk, bf16* WT, LAS float* scr, int item, int lane) {
    const int kb = item / nblk, nb = item % nblk, k0 = 64 * kb, n0 = 32 * nb;
#pragma unroll 8
    for (int i = 0; i < 32; ++i) { const int kk = 2 * i + (lane >> 5); scr[kk * 33 + (lane & 31)] = W[(size_t)(k0 + kk) * ldw + n0 + (lane & 31)]; }
    asm volatile("s_waitcnt lgkmcnt(0)" ::: "memory");
    const int c = lane & 7;
#pragma unroll
    for (int j = 0; j < 4; ++j) { const int n = (lane >> 3) + 8 * j; const LAS float* s = scr + (8 * c) * 33 + n;
        u32x4 o; o.x = cvt_pk_bf16(s[0 * 33], s[1 * 33]); o.y = cvt_pk_bf16(s[2 * 33], s[3 * 33]); o.z = cvt_pk_bf16(s[4 * 33], s[5 * 33]); o.w = cvt_pk_bf16(s[6 * 33], s[7 * 33]);
        *(u32x4*)(WT + (size_t)(n0 + n) * K + k0 + 8 * c) = o; }
    asm volatile("s_waitcnt lgkmcnt(0)" ::: "memory");
}

__device__ __forceinline__ void p0_prologue(const Args& a, LAS unsigned char* lds, int tid, int lane, int wave) {
    unsigned char* ws = a.ws;
    const int gw = blockIdx.x * NWAVES + wave, NGW = gridDim.x * NWAVES;
    const int gt = blockIdx.x * 512 + tid, NGT = gridDim.x * 512;
    { float* r1 = (float*)(ws + WS_RSS1); for (int i = gt; i < 2 * M; i += NGT) r1[i] = 0.f;
      float* sq = (float*)(ws + WS_SSQ); for (int i = gt; i < 2 * M; i += NGT) sq[i] = 0.f;
      float* lb = (float*)(ws + WS_LB); const float* lg = a.in[5];
      for (int i = gt; i < 1024; i += NGT) { const float l0 = lg[i], l1 = lg[1024 + i]; lb[i] = 1.0f / (1.0f + __expf(l1 - l0)); } }
    LAS f32x4* wdt = (LAS f32x4*)lds;
    for (int idx = tid; idx < 4096; idx += 512) { const int ln = idx & 63, c4 = (idx >> 6) & 3, ji = idx >> 8, j = ji >> 2, i = ji & 3, k = 256 * j + 4 * ln + i;
        wdt[idx] = *(const f32x4*)(a.in[7] + (size_t)k * LDWIN + NIN + 4 * c4); }
    __syncthreads();
    LAS float* scr = (LAS float*)(lds + 65536 + wave * 8448);
    constexpr int I_IN = (D / 64) * (NIN / 32), I_OUT = (DMIX / 64) * (D / 32), I_UP = (D / 64) * (FF / 32), I_DN = (FF / 64) * (D / 32);
    for (int it = gw; it < I_IN + I_OUT + I_UP + I_DN; it += NGW) {
        int r = it;
        if (r < I_IN) { p0_transpose_item(a.in[7], LDWIN, D, NIN / 32, (bf16*)(ws + WS_WIN), scr, r, lane); continue; } r -= I_IN;
        if (r < I_OUT) { p0_transpose_item(a.in[15], D, DMIX, D / 32, (bf16*)(ws + WS_WOUT), scr, r, lane); continue; } r -= I_OUT;
        if (r < I_UP) { p0_transpose_item(a.in[17], FF, D, FF / 32, (bf16*)(ws + WS_WUP), scr, r, lane); continue; } r -= I_UP;
        p0_transpose_item(a.in[18], D, FF, D / 32, (bf16*)(ws + WS_WDN), scr, r, lane);
    }
    bf16* XN = (bf16*)(ws + WS_XN); float* DT = (float*)(ws + WS_DT);
    f32x4 gl[4];
#pragma unroll
    for (int j = 0; j < 4; ++j) gl[j] = ((const f32x4*)a.in[6])[lane + 64 * j];
    const float dtb = a.in[11][lane & 15];
    for (int grp = gw; grp < M / 4; grp += NGW) {
        const int r0 = grp * 4;
        f32x4 v[4][4];
#pragma unroll
        for (int r = 0; r < 4; ++r) { const int row = r0 + r; const f32x4* xr = (const f32x4*)((row < MP) ? a.in[0] + (size_t)row * D : a.in[1] + (size_t)(row - MP) * D);
#pragma unroll
            for (int j = 0; j < 4; ++j) v[r][j] = xr[lane + 64 * j]; }
#pragma unroll
        for (int r = 0; r < 4; ++r) { float s = 0.f;
#pragma unroll
            for (int j = 0; j < 4; ++j) s += (v[r][j][0] * v[r][j][0] + v[r][j][1] * v[r][j][1]) + (v[r][j][2] * v[r][j][2] + v[r][j][3] * v[r][j][3]);
            const float rstd = __builtin_amdgcn_rsqf(wave_sum(s) * (1.0f / D) + EPS);
            u32x2* o8 = (u32x2*)(XN + (size_t)(r0 + r) * D);
#pragma unroll
            for (int j = 0; j < 4; ++j) { v[r][j] = v[r][j] * rstd * gl[j]; u32x2 w; w.x = cvt_pk_bf16(v[r][j][0], v[r][j][1]); w.y = cvt_pk_bf16(v[r][j][2], v[r][j][3]); o8[lane + 64 * j] = w; } }
        float ac[64];
#pragma unroll
        for (int i = 0; i < 64; ++i) ac[i] = 0.f;
#pragma unroll
        for (int j = 0; j < 4; ++j)
#pragma unroll
            for (int i = 0; i < 4; ++i)
#pragma unroll
                for (int c4 = 0; c4 < 4; ++c4) { const f32x4 w = wdt[((j * 4 + i) * 4 + c4) * 64 + lane];
#pragma unroll
                    for (int r = 0; r < 4; ++r) { const float hv = v[r][j][i];
                        ac[r * 16 + c4 * 4 + 0] += hv * w[0]; ac[r * 16 + c4 * 4 + 1] += hv * w[1]; ac[r * 16 + c4 * 4 + 2] += hv * w[2]; ac[r * 16 + c4 * 4 + 3] += hv * w[3]; } }
#pragma unroll
        for (int half = 32; half >= 1; half >>= 1) {
            const bool up = (lane & half) != 0;
#pragma unroll
            for (int i = 0; i < half; ++i) { const float send = up ? ac[i] : ac[i + half], keep = up ? ac[i + half] : ac[i]; ac[i] = keep + __shfl_xor(send, half); }
        }
        const float xr_ = ac[0] + dtb;
        DT[(size_t)r0 * 16 + lane] = fmaxf(xr_, 0.f) + log1pf(__expf(-fabsf(xr_)));
    }
}

__device__ __forceinline__ void p6_final(const Args& a, int lane, int wave) {
    float* Y = a.out + O_Y;
    const int gw = blockIdx.x * NWAVES + wave, NGW = gridDim.x * NWAVES;
    f32x4 gl[4];
#pragma unroll
    for (int j = 0; j < 4; ++j) gl[j] = ((const f32x4*)a.in[19])[lane + 64 * j];
    for (int row = gw; row < M; row += NGW) {
        f32x4* p = (f32x4*)(Y + (size_t)row * D); f32x4 v[4]; float ss = 0.f;
#pragma unroll
        for (int j = 0; j < 4; ++j) { v[j] = p[lane + 64 * j];
            if (row >= MP) { const f32x4* pp = (const f32x4*)((const float*)(a.ws + WS_PART) + (size_t)(row - MP) * D) + lane + 64 * j;
                v[j] = v[j] + ((pp[0] + pp[262144]) + (pp[524288] + pp[786432])); }
            ss += (v[j][0] * v[j][0] + v[j][1] * v[j][1]) + (v[j][2] * v[j][2] + v[j][3] * v[j][3]); }
        const float rs = __builtin_amdgcn_rsqf(wave_sum(ss) * (1.0f / D) + EPS);
#pragma unroll
        for (int j = 0; j < 4; ++j) p[lane + 64 * j] = v[j] * rs * gl[j];
    }
}


__device__ __forceinline__ void p3_finish_samples(const Args& a, int lane, int wave) {
    const int gw = blockIdx.x * NWAVES + wave, NGW = gridDim.x * NWAVES;
    f32x4 gl[4];
#pragma unroll
    for (int j = 0; j < 4; ++j) gl[j] = ((const f32x4*)a.in[16])[lane + 64 * j];
    for (int r = gw; r < MS; r += NGW) {
        const f32x4* xr = (const f32x4*)(a.in[1] + (size_t)r * D); const f32x4* pp = (const f32x4*)((const float*)(a.ws + WS_PART) + (size_t)r * D);
        f32x4* x1 = (f32x4*)(a.out + O_Y + (size_t)(MP + r) * D); u32x2* xg = (u32x2*)((bf16*)(a.ws + WS_XG) + (size_t)(MP + r) * D);
        float ss = 0.f;
#pragma unroll
        for (int j = 0; j < 4; ++j) { const int q = lane + 64 * j;
            const f32x4 v = xr[q] + ((pp[q] + pp[q + 262144]) + (pp[q + 524288] + pp[q + 786432]));
            x1[q] = v; ss += (v[0] * v[0] + v[1] * v[1]) + (v[2] * v[2] + v[3] * v[3]);
            const f32x4 g = v * gl[j]; u32x2 w; w.x = cvt_pk_bf16(g[0], g[1]); w.y = cvt_pk_bf16(g[2], g[3]); xg[q] = w; }
        ss = wave_sum(ss);
        if (lane == 0) ((float*)(a.ws + WS_RSS1))[MP + r] = ss;
    }
}
__device__ __forceinline__ void conv_act_elem(const bf16* XBC, const float* conv0, const float* cw, const float* cb, bf16* XBA, size_t idx) {
    const int row = (int)(idx / 1536), col = (int)(idx % 1536);
    float acc = cb[col];
#pragma unroll
    for (int j = 0; j < 4; ++j) { const int off = j - 3; float xv;
        if (row < MP) { const int t = row & 2047; xv = (t + off >= 0) ? bf2f(XBC[(size_t)(row + off) * 1536 + col]) : 0.f; }
        else { const int r = row - MP, b = r >> 3, t = r & 7; xv = (t + off >= 0) ? bf2f(XBC[(size_t)(row + off) * 1536 + col]) : conv0[(size_t)(b * 3 + (3 + t + off)) * 1536 + col]; }
        acc += cw[j * 1536 + col] * xv; }
    XBA[idx] = (bf16)(cvt_pk_bf16(silu_f(acc), 0.f) & 0xffffu);
}
__device__ __forceinline__ void simple_hgrn(LAS float* red, int u, int v, bf16* QZ, const unsigned short* F, const bf16* I, const bf16* G, const float* S0, const float* hgn, float* outP, float* outS) {
    const int lane = v & 63, wv = v >> 6;
    int row0, L, h; const float* s0 = nullptr; float* so;
    if (u < 64) { h = u & 7; row0 = (u >> 3) * 2048; L = 2048; so = outP + (size_t)u * 16384; }
    else { const int us = u - 64; h = us & 7; row0 = MP + (us >> 3) * 8; L = 8; s0 = S0 + (size_t)us * 16384; so = outS + (size_t)us * 16384; }
    float S[128];
#pragma unroll
    for (int k = 0; k < 128; ++k) S[k] = s0 ? s0[k * 128 + v] : 0.f;
    for (int t = 0; t < L; ++t) {
        const size_t row = row0 + t; const float vv = bf2f(I[row * 1024 + h * 128 + v]); float o = 0.f;
#pragma unroll
        for (int k = 0; k < 128; ++k) { const float f = __expf(h2f(F[row * 1024 + h * 128 + k])); S[k] = f * S[k] + (1.0f - f) * vv; o += S[k] * bf2f(QZ[row * 2048 + h * 128 + k]); }
        float ss = wave_sum(o * o); if (lane == 0) red[wv] = ss; __syncthreads(); ss = red[0] + red[1];
        const float res = o * rsqrtf(ss * (1.0f / 128.0f) + EPS) * hgn[h * 128 + v] * bf2f(G[row * 1024 + h * 128 + v]);
        __syncthreads();
        QZ[row * 2048 + h * 128 + v] = (bf16)(cvt_pk_bf16(res, 0.f) & 0xffffu);
    }
#pragma unroll
    for (int k = 0; k < 128; ++k) so[k * 128 + v] = S[k];
}
__device__ __forceinline__ void simple_ssd(LAS float* red, int u, bf16* QZ, const bf16* XBA, const float* DT, const float* S0, const float* a_log, const float* d_skip, const float* mnorm, float* outP, float* outS) {
    const int tid = threadIdx.x, lane = tid & 63, wv = tid >> 6, p = lane;
    int row0, L, b, g; const float* s0 = nullptr; float* so;
    if (u < 16) { b = u >> 1; g = u & 1; row0 = b * 2048; L = 2048; }
    else { const int us = u - 16; b = us >> 1; g = us & 1; row0 = MP + b * 8; L = 8; }
    const int h = g * 8 + wv, ch = h * 64 + p;
    if (u < 16) so = outP + ((size_t)(b * 16 + h) * 64 + p) * 128; else { s0 = S0 + ((size_t)(b * 16 + h) * 64 + p) * 128; so = outS + ((size_t)(b * 16 + h) * 64 + p) * 128; }
    float S[128];
#pragma unroll
    for (int n = 0; n < 128; ++n) S[n] = s0 ? s0[n] : 0.f;
    const float A = -__expf(a_log[h]), Dk = d_skip[h], gain = mnorm[ch];
    for (int t = 0; t < L; ++t) {
        const size_t row = row0 + t; const float dt = DT[row * 16 + h], xs = bf2f(XBA[row * 1536 + ch]), dec = __expf(dt * A), xdt = xs * dt; float y = 0.f;
        const bf16* Bp = XBA + row * 1536 + 1024 + g * 128; const bf16* Cp = XBA + row * 1536 + 1280 + g * 128;
#pragma unroll
        for (int n = 0; n < 128; ++n) { S[n] = dec * S[n] + xdt * bf2f(Bp[n]); y += S[n] * bf2f(Cp[n]); }
        y += Dk * xs; y *= bf2f(QZ[row * 2048 + 1024 + ch]);
        float ss = wave_sum(y * y); if (lane == 0) red[wv] = ss; __syncthreads();
        ss = ((red[0] + red[1]) + (red[2] + red[3])) + ((red[4] + red[5]) + (red[6] + red[7]));
        const float res = y * rsqrtf(ss * (1.0f / 512.0f) + EPS) * gain;
        __syncthreads();
        QZ[row * 2048 + 1024 + ch] = (bf16)(cvt_pk_bf16(res, 0.f) & 0xffffu);
    }
#pragma unroll
    for (int n = 0; n < 128; ++n) so[n] = S[n];
}
__device__ __forceinline__ unsigned pkbf(float lo, float hi) { unsigned r; asm("v_cvt_pk_bf16_f32 %0, %1, %2" : "=v"(r) : "v"(lo), "v"(hi)); return r; }
__device__ __forceinline__ bf16x8 pack8(f32x4 a, f32x4 b) { u32x4 w; w.x = pkbf(a[0], a[1]); w.y = pkbf(a[2], a[3]); w.z = pkbf(b[0], b[1]); w.w = pkbf(b[2], b[3]); return __builtin_bit_cast(bf16x8, w); }
__device__ __forceinline__ float lo16(unsigned u) { return __uint_as_float(u << 16); }
__device__ __forceinline__ float hi16(unsigned u) { return __uint_as_float(u & 0xffff0000u); }
__device__ __forceinline__ void st_sc1_8(void* p, u32x2 v) { __hip_atomic_store((unsigned long long*)p, (unsigned long long)v.x | ((unsigned long long)v.y << 32), __ATOMIC_RELAXED, __HIP_MEMORY_SCOPE_AGENT); }
__device__ __forceinline__ void st_sc1_16(void* p, u32x4 v) { asm volatile("global_store_dwordx4 %0, %1, off sc1\n\ts_nop 1" :: "v"(p), "v"(v) : "memory"); }
#define MFMA16(a, b, c) __builtin_amdgcn_mfma_f32_16x16x32_bf16((a), (b), (c), 0, 0, 0)
#define WG_BAR() do { asm volatile("s_waitcnt lgkmcnt(0)" ::: "memory"); __builtin_amdgcn_s_barrier(); asm volatile("" ::: "memory"); } while (0)
constexpr int E_QD = 0, E_KD = 8704, E_KET = 17408, E_VT = 27648, E_VTE = 68608, E_TOT = 109568, E_DEC = 113664, E_RED = 114176, E_CUM = 115200, E_DTV = 116224, E_TOTH = 117248;
constexpr int QP = 272, KP = 80;

struct GlaP {
    int row0, ntok, nch, seq_t0, head, half, samp_b;
    const float* Sinit; int init_lay;
    int nprev; const float* Dprev;
    float* Sout; int out_lay;
    float* Dout;
};

template <int MODE, bool OUT>
__device__ __forceinline__ void gla_unit(LAS unsigned char* lds, const GlaP P, const Args& args, int lane, int w) {
    constexpr int NV = MODE == 0 ? 1 : 2;
    const int fr = lane & 15, fq = lane >> 4;
    const int vbase = MODE == 0 ? 16 * w : 32 * w;
    const int hl = w >> 1;
    unsigned char* ws = args.ws;
    bf16* QZ = (bf16*)(ws + WS_QZ);
    const unsigned short* Fb = (const unsigned short*)(ws + WS_F);
    const bf16* Ib = (const bf16*)(args.out) + (size_t)M * 1024;
    const bf16* Gb = (const bf16*)(args.out);
    const bf16* XBC = (const bf16*)(ws + WS_XBC);
    const float* DT = (const float*)(ws + WS_DT);
    const int posoff = 2 * (8 * (w & 3) + 4 * (w >> 2));
    LAS float* TOT = (LAS float*)(lds + E_TOT); LAS float* DEC = (LAS float*)(lds + E_DEC); LAS float* RED = (LAS float*)(lds + E_RED);
    LAS float* CUM = (LAS float*)(lds + E_CUM); LAS float* DTV = (LAS float*)(lds + E_DTV); LAS float* TOTH = (LAS float*)(lds + E_TOTH);
    f32x4 S[8][NV];
    if (P.init_lay == 0) {
#pragma unroll
        for (int kt = 0; kt < 8; ++kt)
#pragma unroll
            for (int vt = 0; vt < NV; ++vt) S[kt][vt] = (f32x4){0.f, 0.f, 0.f, 0.f};
    } else if (P.init_lay == 2) {
        const f32x4* sp = (const f32x4*)P.Sinit;
#pragma unroll
        for (int kt = 0; kt < 8; ++kt)
#pragma unroll
            for (int vt = 0; vt < NV; ++vt) S[kt][vt] = sp[((w * 8 + kt) * NV + vt) * 64 + lane];
    } else {
        if constexpr (MODE == 0) {
#pragma unroll
            for (int kt = 0; kt < 8; ++kt)
#pragma unroll
                for (int r = 0; r < 4; ++r) S[kt][0][r] = P.Sinit[(size_t)(16 * kt + 4 * fq + r) * 128 + 16 * w + fr];
        } else {
            const float* sb = P.Sinit + (size_t)hl * 8192 + (size_t)(32 * (w & 1)) * 128;
#pragma unroll
            for (int kt = 0; kt < 8; ++kt)
#pragma unroll
                for (int vt = 0; vt < NV; ++vt) S[kt][vt] = *(const f32x4*)(sb + (size_t)(16 * vt + fr) * 128 + 16 * kt + 4 * fq);
        }
    }
    float slog0 = 0.f, slog1 = 0.f;
    const int hh = MODE == 0 ? P.head : 8 * P.head + 4 * P.half + hl;
    float A_h = 0.f, Dsk = 0.f;
    if constexpr (MODE == 1) { A_h = -__expf(args.in[12][hh]); Dsk = args.in[13][hh]; }

    unsigned rawq[4] = {0u, 0u, 0u, 0u}, rawf[4] = {0u, 0u, 0u, 0u}, rawv[4] = {0u, 0u, 0u, 0u};
#define HG_PREFETCH(cc_) do { if constexpr (MODE == 0) { _Pragma("unroll") for (int i_ = 0; i_ < 4; ++i_) { const int t_ = 32 * (cc_) + 4 * w + i_; \
        if (t_ < P.ntok) { const size_t row_ = (size_t)(P.row0 + t_); rawf[i_] = *(const unsigned*)(Fb + row_ * 1024 + hh * 128 + 2 * lane); rawv[i_] = *(const unsigned*)(Ib + row_ * 1024 + hh * 128 + 2 * lane); \
            rawq[i_] = OUT ? *(const unsigned*)(QZ + row_ * 2048 + hh * 128 + 2 * lane) : 0u; } \
        else { rawf[i_] = 0u; rawv[i_] = 0u; rawq[i_] = 0u; } } } } while (0)
    HG_PREFETCH(0);
    const bool usepf = MODE == 1 && P.samp_b < 0;
    unsigned pC[7] = {0u, 0u, 0u, 0u, 0u, 0u, 0u};
    unsigned pB[7] = {0u, 0u, 0u, 0u, 0u, 0u, 0u}, pX[2][7] = {{0u, 0u, 0u, 0u, 0u, 0u, 0u}, {0u, 0u, 0u, 0u, 0u, 0u, 0u}}; float pdt = 0.f;
#define SS_PREFETCH(cc_) do { if constexpr (MODE == 1) { if (usepf) { _Pragma("unroll") for (int j_ = 0; j_ < 7; ++j_) { const int tr_ = 32 * (cc_) + 4 * w - 3 + j_; \
        if (tr_ < P.ntok && tr_ + P.seq_t0 >= 0) { const bf16* rp_ = XBC + (size_t)(P.row0 + tr_) * 1536; pB[j_] = *(const unsigned*)(rp_ + 1024 + P.head * 128 + 2 * lnq); if (OUT) pC[j_] = *(const unsigned*)(rp_ + 1280 + P.head * 128 + 2 * lnq); \
            pX[0][j_] = *(const unsigned*)(rp_ + P.head * 512 + 256 * P.half + 2 * lnq); pX[1][j_] = *(const unsigned*)(rp_ + P.head * 512 + 256 * P.half + 128 + 2 * lnq); } \
        else { pB[j_] = 0u; pC[j_] = 0u; pX[0][j_] = 0u; pX[1][j_] = 0u; } } \
        { const int tk_ = 32 * (cc_) + (lnq & 31); pdt = (tk_ < P.ntok) ? DT[(size_t)(P.row0 + tk_) * 16 + hh] : 0.f; } } } } while (0)
    { int lnq = lane; asm volatile("" : "+v"(lnq)); SS_PREFETCH(0); }
    u32x2 gpre[2] = {{0u, 0u}, {0u, 0u}};
    for (int c = 0; c < P.nch; ++c) {
        const int tb = 32 * c + 4 * w;
        if constexpr (MODE == 0) {
            float q[4][2], lf[4][2], vv[4][2];
#pragma unroll
            for (int i = 0; i < 4; ++i) {
                lf[i][0] = h2f((unsigned short)(rawf[i] & 0xffffu)); lf[i][1] = h2f((unsigned short)(rawf[i] >> 16));
                vv[i][0] = lo16(rawv[i]); vv[i][1] = hi16(rawv[i]);
                q[i][0] = lo16(rawq[i]); q[i][1] = hi16(rawq[i]);
            }
            if (c + 1 < P.nch) HG_PREFETCH(c + 1);
            float cs[4][2];
#pragma unroll
            for (int e = 0; e < 2; ++e) { cs[0][e] = lf[0][e]; cs[1][e] = cs[0][e] + lf[1][e]; cs[2][e] = cs[1][e] + lf[2][e]; cs[3][e] = cs[2][e] + lf[3][e]; }
            *(LAS f32x2*)(TOT + w * 128 + 2 * lane) = (f32x2){cs[3][0], cs[3][1]};
            WG_BAR();
            float pre[2] = {0.f, 0.f}, tot[2] = {0.f, 0.f};
#pragma unroll
            for (int g = 0; g < 8; ++g) { const f32x2 tv = *(const LAS f32x2*)(TOT + g * 128 + 2 * lane); tot[0] += tv.x; tot[1] += tv.y; if (g < w) { pre[0] += tv.x; pre[1] += tv.y; } }
            float qd[4][2], kd[4][2], ke[4][2];
#pragma unroll
            for (int i = 0; i < 4; ++i)
#pragma unroll
                for (int e = 0; e < 2; ++e) { const float cum = pre[e] + cs[i][e], kk = 1.0f - __expf(lf[i][e]);
                    qd[i][e] = q[i][e] * __expf(cum); kd[i][e] = kk * __expf(-cum); ke[i][e] = kk * __expf(tot[e] - cum); }
            if (OUT) {
#pragma unroll
                for (int i = 0; i < 4; ++i) { *(LAS unsigned*)(lds + E_QD + (4 * w + i) * QP + 4 * lane) = pkbf(qd[i][0], qd[i][1]); *(LAS unsigned*)(lds + E_KD + (4 * w + i) * QP + 4 * lane) = pkbf(kd[i][0], kd[i][1]); }
            }
#pragma unroll
            for (int e = 0; e < 2; ++e) {
                u32x2 a; a.x = pkbf(ke[0][e], ke[1][e]); a.y = pkbf(ke[2][e], ke[3][e]); *(LAS u32x2*)(lds + E_KET + (2 * lane + e) * KP + posoff) = a;
                u32x2 b; b.x = pkbf(vv[0][e], vv[1][e]); b.y = pkbf(vv[2][e], vv[3][e]); *(LAS u32x2*)(lds + E_VT + (2 * lane + e) * KP + posoff) = b;
            }
            if (w == 0) { *(LAS f32x2*)(DEC + 2 * lane) = (f32x2){__expf(tot[0]), __expf(tot[1])}; slog0 += tot[0]; slog1 += tot[1]; }
            WG_BAR();
            if (OUT) {
#pragma unroll
                for (int tt = 0; tt < 2; ++tt) { const int tok = 32 * c + 16 * tt + fr; gpre[tt] = *(const u32x2*)(Gb + (size_t)(P.row0 + (tok < P.ntok ? tok : 0)) * 1024 + hh * 128 + vbase + 4 * fq); }
            }
        } else {
            const int g = P.head;
            int lnq = lane; asm volatile("" : "+v"(lnq));
            auto ldraw = [&](int col, int tokrel, float& x0, float& x1) {
                if (tokrel >= P.ntok) { x0 = 0.f; x1 = 0.f; }
                else if (tokrel + P.seq_t0 >= 0) { const unsigned a = *(const unsigned*)(XBC + (size_t)(P.row0 + tokrel) * 1536 + col); x0 = lo16(a); x1 = hi16(a); }
                else if (P.samp_b >= 0) { const f32x2 a = *(const f32x2*)(args.in[4] + (size_t)(P.samp_b * 3 + 3 + tokrel) * 1536 + col); x0 = a.x; x1 = a.y; }
                else { x0 = 0.f; x1 = 0.f; }
            };
            auto convact = [&](int col, float (&o)[4][2]) {
                float rr[7][2];
#pragma unroll
                for (int j = 0; j < 7; ++j) ldraw(col, tb - 3 + j, rr[j][0], rr[j][1]);
                const f32x2 cb = *(const f32x2*)(args.in[10] + col);
                f32x2 cw[4];
#pragma unroll
                for (int j = 0; j < 4; ++j) cw[j] = *(const f32x2*)(args.in[9] + j * 1536 + col);
#pragma unroll
                for (int i = 0; i < 4; ++i) {
                    float a0 = cb.x, a1 = cb.y;
#pragma unroll
                    for (int j = 0; j < 4; ++j) { a0 += cw[j].x * rr[i + j][0]; a1 += cw[j].y * rr[i + j][1]; }
                    const bool ok = (tb + i) < P.ntok;
                    o[i][0] = ok ? silu_f(a0) : 0.f; o[i][1] = ok ? silu_f(a1) : 0.f;
                }
            };
            auto convraw = [&](int col, const unsigned (&raw)[7], float (&o)[4][2]) {
                const f32x2 cb = *(const f32x2*)(args.in[10] + col);
                f32x2 cw[4];
#pragma unroll
                for (int j = 0; j < 4; ++j) cw[j] = *(const f32x2*)(args.in[9] + j * 1536 + col);
#pragma unroll
                for (int i = 0; i < 4; ++i) {
                    float a0 = cb.x, a1 = cb.y;
#pragma unroll
                    for (int j = 0; j < 4; ++j) { a0 += cw[j].x * lo16(raw[i + j]); a1 += cw[j].y * hi16(raw[i + j]); }
                    const bool ok = (tb + i) < P.ntok;
                    o[i][0] = ok ? silu_f(a0) : 0.f; o[i][1] = ok ? silu_f(a1) : 0.f;
                }
            };
            {
                const int l = lane & 31, tok = 32 * c + l;
                const float dt = usepf ? pdt : ((tok < P.ntok) ? DT[(size_t)(P.row0 + tok) * 16 + hh] : 0.f);
                float x = dt * A_h;
#pragma unroll
                for (int o = 1; o < 32; o <<= 1) { const float y = __shfl_up(x, o, 32); if (l >= o) x += y; }
                if (lane < 32) { CUM[hl * 32 + l] = x; DTV[hl * 32 + l] = dt; }
                const float th = __shfl(x, 31, 32);
                if (lane == 0) TOTH[hl] = th;
                slog0 += th;
            }
            {
                float ba[4][2];
                if (usepf) convraw(1024 + g * 128 + 2 * lnq, pB, ba); else convact(1024 + g * 128 + 2 * lnq, ba);
                u32x2 a0, a1; a0.x = pkbf(ba[0][0], ba[1][0]); a0.y = pkbf(ba[2][0], ba[3][0]); a1.x = pkbf(ba[0][1], ba[1][1]); a1.y = pkbf(ba[2][1], ba[3][1]);
                *(LAS u32x2*)(lds + E_KET + (2 * lane) * KP + posoff) = a0; *(LAS u32x2*)(lds + E_KET + (2 * lane + 1) * KP + posoff) = a1;
                if (OUT) {
#pragma unroll
                    for (int i = 0; i < 4; ++i) *(LAS unsigned*)(lds + E_KD + (4 * w + i) * QP + 4 * lane) = pkbf(ba[i][0], ba[i][1]);
                    float ca[4][2];
                    if (usepf) convraw(1280 + g * 128 + 2 * lnq, pC, ca); else convact(1280 + g * 128 + 2 * lnq, ca);
#pragma unroll
                    for (int i = 0; i < 4; ++i) *(LAS unsigned*)(lds + E_QD + (4 * w + i) * QP + 4 * lane) = pkbf(ca[i][0], ca[i][1]);
                }
            }
            WG_BAR();
#pragma unroll 1
            for (int jj = 0; jj < 2; ++jj) {
                const int cl = 2 * (lnq + 64 * jj), hc = cl >> 6;
                float xa[4][2];
                if (usepf) { if (jj == 0) convraw(g * 512 + 256 * P.half + cl, pX[0], xa); else convraw(g * 512 + 256 * P.half + cl, pX[1], xa); } else convact(g * 512 + 256 * P.half + cl, xa);
                const float th = TOTH[hc];
                float xd[4][2], xe[4][2];
#pragma unroll
                for (int i = 0; i < 4; ++i) { const float dtv = DTV[hc * 32 + 4 * w + i], te = __expf(th - CUM[hc * 32 + 4 * w + i]);
                    xd[i][0] = xa[i][0] * dtv; xd[i][1] = xa[i][1] * dtv; xe[i][0] = xd[i][0] * te; xe[i][1] = xd[i][1] * te; }
#pragma unroll
                for (int e = 0; e < 2; ++e) {
                    u32x2 b; b.x = pkbf(xe[0][e], xe[1][e]); b.y = pkbf(xe[2][e], xe[3][e]); *(LAS u32x2*)(lds + E_VTE + (cl + e) * KP + posoff) = b;
                    if (OUT) { u32x2 a; a.x = pkbf(xd[0][e], xd[1][e]); a.y = pkbf(xd[2][e], xd[3][e]); *(LAS u32x2*)(lds + E_VT + (cl + e) * KP + posoff) = a; }
                }
            }
            WG_BAR();
            if (c + 1 < P.nch) SS_PREFETCH(c + 1);
        }
        bf16x8 Pm[2];
        float ecum[2] = {1.f, 1.f};
        if (OUT) {
            f32x4 a00 = {0.f, 0.f, 0.f, 0.f}, a01 = a00, a11 = a00;
#pragma unroll
            for (int kk = 0; kk < 4; ++kk) {
                const bf16x8 k0 = *(const LAS bf16x8*)(lds + E_KD + fr * QP + 64 * kk + 16 * fq), k1 = *(const LAS bf16x8*)(lds + E_KD + (16 + fr) * QP + 64 * kk + 16 * fq);
                const bf16x8 q0 = *(const LAS bf16x8*)(lds + E_QD + fr * QP + 64 * kk + 16 * fq), q1 = *(const LAS bf16x8*)(lds + E_QD + (16 + fr) * QP + 64 * kk + 16 * fq);
                a00 = MFMA16(k0, q0, a00); a01 = MFMA16(k0, q1, a01); a11 = MFMA16(k1, q1, a11);
            }
            f32x4 z4 = {0.f, 0.f, 0.f, 0.f};
            if constexpr (MODE == 0) {
#pragma unroll
                for (int r = 0; r < 4; ++r) { const bool keep = (4 * fq + r) <= fr; a00[r] = keep ? a00[r] : 0.f; a11[r] = keep ? a11[r] : 0.f; }
            } else {
                const float ct0 = CUM[hl * 32 + fr], ct1 = CUM[hl * 32 + 16 + fr], dt0 = DTV[hl * 32 + fr], dt1 = DTV[hl * 32 + 16 + fr];
                const f32x4 cs0 = *(const LAS f32x4*)(CUM + hl * 32 + 4 * fq), cs1 = *(const LAS f32x4*)(CUM + hl * 32 + 16 + 4 * fq);
                const float dg0 = dt0 > 0.f ? Dsk / dt0 : 0.f, dg1 = dt1 > 0.f ? Dsk / dt1 : 0.f;
#pragma unroll
                for (int r = 0; r < 4; ++r) { const int s = 4 * fq + r; const bool keep = s <= fr, dg = s == fr;
                    const float v00 = a00[r] * __expf(fminf(ct0 - cs0[r], 0.f)), v01 = a01[r] * __expf(fminf(ct1 - cs0[r], 0.f)), v11 = a11[r] * __expf(fminf(ct1 - cs1[r], 0.f));
                    a00[r] = (keep ? v00 : 0.f) + (dg ? dg0 : 0.f); a01[r] = v01; a11[r] = (keep ? v11 : 0.f) + (dg ? dg1 : 0.f); }
                ecum[0] = __expf(ct0); ecum[1] = __expf(ct1);
            }
            Pm[0] = pack8(a00, z4); Pm[1] = pack8(a01, a11);
        }
        f32x4 o[NV][2];
#pragma unroll
        for (int vt = 0; vt < NV; ++vt) {
            asm volatile("" ::: "memory");
            const bf16x8 vtf = *(const LAS bf16x8*)(lds + E_VT + (vbase + 16 * vt + fr) * KP + 16 * fq);
            if (OUT) {
                f32x4 o0 = {0.f, 0.f, 0.f, 0.f}, o1 = o0;
#pragma unroll
                for (int j = 0; j < 4; ++j) {
                    const bf16x8 sb = pack8(S[2 * j][vt], S[2 * j + 1][vt]);
                    const u32x2 qa = *(const LAS u32x2*)(lds + E_QD + fr * QP + 64 * j + 8 * fq), qb = *(const LAS u32x2*)(lds + E_QD + fr * QP + 64 * j + 32 + 8 * fq);
                    const u32x2 qc = *(const LAS u32x2*)(lds + E_QD + (16 + fr) * QP + 64 * j + 8 * fq), qe = *(const LAS u32x2*)(lds + E_QD + (16 + fr) * QP + 64 * j + 32 + 8 * fq);
                    u32x4 t0; t0.x = qa.x; t0.y = qa.y; t0.z = qb.x; t0.w = qb.y; u32x4 t1; t1.x = qc.x; t1.y = qc.y; t1.z = qe.x; t1.w = qe.y;
                    o0 = MFMA16(sb, __builtin_bit_cast(bf16x8, t0), o0); o1 = MFMA16(sb, __builtin_bit_cast(bf16x8, t1), o1);
                }
                if constexpr (MODE == 1) { o0 = o0 * ecum[0]; o1 = o1 * ecum[1]; }
                o0 = MFMA16(vtf, Pm[0], o0); o1 = MFMA16(vtf, Pm[1], o1);
                o[vt][0] = o0; o[vt][1] = o1;
            }
            bf16x8 vte = vtf;
            if constexpr (MODE == 1) vte = *(const LAS bf16x8*)(lds + E_VTE + (vbase + 16 * vt + fr) * KP + 16 * fq);
            float dsc = 1.f;
            if constexpr (MODE == 1) dsc = __expf(TOTH[hl]);
#pragma unroll
            for (int kt = 0; kt < 8; ++kt) {
                const bf16x8 kf = *(const LAS bf16x8*)(lds + E_KET + (16 * kt + fr) * KP + 16 * fq);
                f32x4 sc;
                if constexpr (MODE == 0) sc = S[kt][vt] * *(const LAS f32x4*)(DEC + 16 * kt + 4 * fq); else sc = S[kt][vt] * dsc;
                S[kt][vt] = MFMA16(kf, vte, sc);
            }
        }
        if (OUT) {
            if constexpr (MODE == 0) {
                f32x4 gz[2]; bool val[2]; size_t rowt[2];
#pragma unroll
                for (int tt = 0; tt < 2; ++tt) {
                    const int tok = 32 * c + 16 * tt + fr; val[tt] = tok < P.ntok; rowt[tt] = (size_t)(P.row0 + (val[tt] ? tok : 0));
                    const u32x2 gg = gpre[tt];
                    gz[tt] = (f32x4){lo16(gg.x), hi16(gg.x), lo16(gg.y), hi16(gg.y)};
                    const f32x4 y = o[0][tt]; float ss = (y[0] * y[0] + y[1] * y[1]) + (y[2] * y[2] + y[3] * y[3]);
                    ss += __shfl_xor(ss, 16); ss += __shfl_xor(ss, 32);
                    if (fq == 0) RED[(16 * tt + fr) * 8 + w] = ss;
                }
                WG_BAR();
                const f32x4 gn = *(const f32x4*)(args.in[8] + hh * 128 + vbase + 4 * fq);
#pragma unroll
                for (int tt = 0; tt < 2; ++tt) {
                    const f32x4 r0 = *(const LAS f32x4*)(RED + (16 * tt + fr) * 8), r1 = *(const LAS f32x4*)(RED + (16 * tt + fr) * 8 + 4);
                    const float tot = ((r0[0] + r0[1]) + (r0[2] + r0[3])) + ((r1[0] + r1[1]) + (r1[2] + r1[3]));
                    const float rstd = __builtin_amdgcn_rsqf(tot * (1.0f / 128.0f) + EPS);
                    const f32x4 res = o[0][tt] * rstd * gn * gz[tt];
                    u32x2 wv; wv.x = pkbf(res[0], res[1]); wv.y = pkbf(res[2], res[3]);
                    if (val[tt]) *(u32x2*)(QZ + rowt[tt] * 2048 + hh * 128 + vbase + 4 * fq) = wv;
                }
            } else {
                float* SSQ = (float*)(ws + WS_SSQ);
#pragma unroll
                for (int tt = 0; tt < 2; ++tt) {
                    const int tok = 32 * c + 16 * tt + fr; const bool val = tok < P.ntok; const size_t row = (size_t)(P.row0 + (val ? tok : 0));
                    float ss = 0.f;
#pragma unroll
                    for (int vt = 0; vt < NV; ++vt) {
                        bf16* zp = QZ + row * 2048 + 1024 + P.head * 512 + 256 * P.half + vbase + 16 * vt + 4 * fq;
                        const u32x2 gg = *(const u32x2*)zp;
                        const f32x4 y = o[vt][tt] * (f32x4){lo16(gg.x), hi16(gg.x), lo16(gg.y), hi16(gg.y)};
                        u32x2 wv; wv.x = pkbf(y[0], y[1]); wv.y = pkbf(y[2], y[3]);
                        const f32x4 yr = {lo16(wv.x), hi16(wv.x), lo16(wv.y), hi16(wv.y)};
                        ss += (yr[0] * yr[0] + yr[1] * yr[1]) + (yr[2] * yr[2] + yr[3] * yr[3]);
                        if (val) *(u32x2*)zp = wv;
                    }
                    ss += __shfl_xor(ss, 16); ss += __shfl_xor(ss, 32);
                    if (fq == 0 && val) unsafeAtomicAdd(SSQ + row * 2 + P.head, ss);
                }
                WG_BAR();
            }
        } else {
            WG_BAR();
        }
    }
    if (P.out_lay == 2) {
        f32x4* sp = (f32x4*)P.Sout;
#pragma unroll
        for (int kt = 0; kt < 8; ++kt)
#pragma unroll
            for (int vt = 0; vt < NV; ++vt) sp[((w * 8 + kt) * NV + vt) * 64 + lane] = S[kt][vt];
    } else if (P.out_lay == 1) {
        if constexpr (MODE == 0) {
#pragma unroll
            for (int kt = 0; kt < 8; ++kt)
#pragma unroll
                for (int r = 0; r < 4; ++r) P.Sout[(size_t)(16 * kt + 4 * fq + r) * 128 + 16 * w + fr] = S[kt][0][r];
        } else {
            float* sb = P.Sout + (size_t)hl * 8192 + (size_t)(32 * (w & 1)) * 128;
#pragma unroll
            for (int kt = 0; kt < 8; ++kt)
#pragma unroll
                for (int vt = 0; vt < NV; ++vt) *(f32x4*)(sb + (size_t)(16 * vt + fr) * 128 + 16 * kt + 4 * fq) = S[kt][vt];
        }
    }
    if (P.Dout) {
        if constexpr (MODE == 0) { if (w == 0) *(f32x2*)(P.Dout + 2 * lane) = (f32x2){__expf(slog0), __expf(slog1)}; }
        else { if (lane == 0 && (w & 1) == 0) P.Dout[hl] = __expf(slog0); }
    }
    (void)slog1;
}
#ifndef ENG_H
#define ENG_H 1
#endif
#ifndef ENG_S
#define ENG_S 1
#endif

__device__ __forceinline__ float* hseg_slot(unsigned char* ws, int bh, int s) { return (float*)(ws + WS_HSEG) + ((size_t)bh * 3 + s) * 16384; }
__device__ __forceinline__ float* sseg_slot(unsigned char* ws, int bg, int s) { return (float*)(ws + WS_SSEG) + ((size_t)bg * 7 + s) * 32768; }

__device__ __forceinline__ void phase_2a(LAS unsigned char* lds, const Args& args, int lane, int w) {
    unsigned char* ws = args.ws;
    for (int i = blockIdx.x; i < 256; i += gridDim.x) {
        if (ENG_H && i < 192) {
            const int bh = i / 3, seg = i % 3;
            GlaP p; p.row0 = (bh >> 3) * 2048 + seg * 512; p.ntok = 512; p.nch = 16; p.seq_t0 = seg * 512; p.head = bh & 7; p.half = 0; p.samp_b = -1;
            p.Sinit = nullptr; p.init_lay = 0; p.Sout = hseg_slot(ws, bh, seg); p.out_lay = 2; p.Dout = (float*)(ws + WS_HD) + (bh * 3 + seg) * 128;
            gla_unit<0, false>(lds, p, args, lane, w);
        }
        const int j0 = (i >= 192) ? 2 * (i - 192) : (i < 96 ? 128 + i : 0), nj = !ENG_S ? 0 : (i >= 192) ? 2 : (i < 96 ? 1 : 0);
        for (int j = j0; j < j0 + nj; ++j) {
            const int u = j / 7, seg = j % 7, b = u >> 2, g = (u >> 1) & 1;
            GlaP p; p.row0 = b * 2048 + seg * 256; p.ntok = 256; p.nch = 8; p.seq_t0 = seg * 256; p.head = g; p.half = u & 1; p.samp_b = -1;
            p.Sinit = nullptr; p.init_lay = 0; p.Sout = sseg_slot(ws, u, seg); p.out_lay = 2; p.Dout = (float*)(ws + WS_SD) + (u * 7 + seg) * 32;
            gla_unit<1, false>(lds, p, args, lane, w);
        }
    }
}
__device__ __forceinline__ void phase_2b(const Args& args, int tid) {
    unsigned char* ws = args.ws;
    const int gt = blockIdx.x * 512 + tid, NGT = gridDim.x * 512;
    for (int it = gt; it < 64 * 4096; it += NGT) {
        const int bh = it >> 12, e4 = it & 4095, kt = (e4 >> 6) & 7, fq = (e4 & 63) >> 4, k = 16 * kt + 4 * fq;
        f32x4 s = ((const f32x4*)hseg_slot(ws, bh, 0))[e4];
#pragma unroll
        for (int sl = 1; sl < 3; ++sl) { const f32x4 d = *(const f32x4*)((const float*)(ws + WS_HD) + (bh * 3 + sl) * 128 + k); f32x4* p = (f32x4*)hseg_slot(ws, bh, sl) + e4; s = d * s + *p; *p = s; }
    }
    for (int it = gt; it < 32 * 8192; it += NGT) {
        const int bg = it >> 13, e4 = it & 8191, wv = e4 >> 10;
        f32x4 s = ((const f32x4*)sseg_slot(ws, bg, 0))[e4];
#pragma unroll
        for (int sl = 1; sl < 7; ++sl) { const float d = ((const float*)(ws + WS_SD))[(bg * 7 + sl) * 32 + (wv >> 1)]; f32x4* p = (f32x4*)sseg_slot(ws, bg, sl) + e4; s = s * d + *p; *p = s; }
    }
}
__device__ __forceinline__ void phase_2c(LAS unsigned char* lds, const Args& args, int lane, int w) {
    unsigned char* ws = args.ws;
    for (int i = blockIdx.x; i < 256; i += gridDim.x) {
        for (int n0 = 0; n0 < (ENG_S ? 3 : 0); ++n0) {
            const int n = (i & 1) ? (n0 + 1) % 3 : n0;
            GlaP p; p.Dout = nullptr;
            if (n == 0) { const int u = i >> 3, seg = i & 7, b = u >> 2, g = (u >> 1) & 1;
                p.row0 = b * 2048 + seg * 256; p.ntok = 256; p.nch = 8; p.seq_t0 = seg * 256; p.head = g; p.half = u & 1; p.samp_b = -1;
                p.Sinit = seg ? sseg_slot(ws, u, seg - 1) : nullptr; p.init_lay = seg ? 2 : 0;
                p.Sout = (seg == 7) ? args.out + O_SSP + (size_t)(b * 16 + 8 * g + 4 * (u & 1)) * 8192 : nullptr; p.out_lay = (seg == 7) ? 1 : 0;
            } else { const int u = 2 * i + n - 1, b = u >> 2, g = (u >> 1) & 1;
                p.row0 = MP + 8 * b; p.ntok = 8; p.nch = 1; p.seq_t0 = 0; p.head = g; p.half = u & 1; p.samp_b = b;
                p.Sinit = args.in[3] + (size_t)(b * 16 + 8 * g + 4 * (u & 1)) * 8192; p.init_lay = 1; p.Sout = args.out + O_SSS + (size_t)(b * 16 + 8 * g + 4 * (u & 1)) * 8192; p.out_lay = 1; }
            gla_unit<1, true>(lds, p, args, lane, w);
        }
        for (int n0 = 0; n0 < (ENG_H ? 5 : 0); ++n0) {
            const int n = (i & 1) ? (n0 + 1) % 5 : n0;
            GlaP p; p.Dout = nullptr; p.half = 0;
            if (n == 0) { const int bh = i >> 2, seg = i & 3;
                p.row0 = (bh >> 3) * 2048 + seg * 512; p.ntok = 512; p.nch = 16; p.seq_t0 = seg * 512; p.head = bh & 7; p.samp_b = -1;
                p.Sinit = seg ? hseg_slot(ws, bh, seg - 1) : nullptr; p.init_lay = seg ? 2 : 0;
                p.Sout = (seg == 3) ? args.out + O_HGP + (size_t)bh * 16384 : nullptr; p.out_lay = (seg == 3) ? 1 : 0;
            } else { const int u = 4 * i + n - 1, b = u >> 3;
                p.row0 = MP + 8 * b; p.ntok = 8; p.nch = 1; p.seq_t0 = 0; p.head = u & 7; p.samp_b = b;
                p.Sinit = args.in[2] + (size_t)u * 16384; p.init_lay = 1; p.Sout = args.out + O_HGS + (size_t)u * 16384; p.out_lay = 1; }
            gla_unit<0, true>(lds, p, args, lane, w);
        }
    }
}
__device__ __forceinline__ void phase_2d(const Args& args, int tid) {
    unsigned char* ws = args.ws; bf16* QZ = (bf16*)(ws + WS_QZ); const float* SSQ = (const float*)(ws + WS_SSQ);
    for (int it = blockIdx.x * 512 + tid; it < M * 128; it += gridDim.x * 512) {
        const int row = it >> 7, c8 = (it & 127) * 8, g = c8 >> 9;
        const float rs = __builtin_amdgcn_rsqf(SSQ[row * 2 + g] * (1.0f / 512.0f) + EPS);
        u32x4* p = (u32x4*)(QZ + (size_t)row * 2048 + 1024 + c8); const u32x4 v = *p;
        const f32x4 g0 = *(const f32x4*)(args.in[14] + c8), g1 = *(const f32x4*)(args.in[14] + c8 + 4);
        u32x4 o; o.x = pkbf(lo16(v.x) * rs * g0[0], hi16(v.x) * rs * g0[1]); o.y = pkbf(lo16(v.y) * rs * g0[2], hi16(v.y) * rs * g0[3]);
        o.z = pkbf(lo16(v.z) * rs * g1[0], hi16(v.z) * rs * g1[1]); o.w = pkbf(lo16(v.w) * rs * g1[2], hi16(v.w) * rs * g1[3]);
        *p = o;
    }
}
__global__ void __launch_bounds__(NWAVES * 64, 2) mega(Args args) {
    extern __shared__ __attribute__((aligned(16))) unsigned char lds_raw[];
    LAS unsigned char* lds = (LAS unsigned char*)lds_raw;
    const int tid = threadIdx.x, lane = tid & 63, wave = __builtin_amdgcn_readfirstlane(tid >> 6);
    const int lo = args.ph_lo, hi = args.ph_hi, G = gridDim.x;
    unsigned char* ws = args.ws;
#define IN(k) (lo <= (k) && (k) < hi)
    volatile LAS unsigned* bst = (volatile LAS unsigned*)(lds + LDS_BYTES - 64);
    if (tid < 2) bst[tid] = 0u;
    __syncthreads();
    XcdBarrier bar = xcd_barrier_post((unsigned*)(ws + WS_BAR), bst);
#define SEAM(k) do { if (IN(k) && IN((k) + 1)) { xcd_barrier(bar); } } while (0)
    if (IN(0)) { p0_prologue(args, lds, tid, lane, wave); __syncthreads(); }
    SEAM(0);
    if (IN(1)) {
        pg8::Gemm g{(const bf16*)(ws + WS_XN), (const bf16*)(ws + WS_WIN), M, NIN, D, D}; pg8::StaticOrder S; S.init(M, NIN, G, (int)blockIdx.x);
        pg8::EpiIn E{(bf16*)(ws + WS_QZ), (bf16*)(ws + WS_F), (bf16*)(args.out) + (size_t)M * 1024, (bf16*)(args.out), (bf16*)(ws + WS_XBC), (const float*)(ws + WS_LB), args.out + O_CVP, args.out + O_CVS};
        pg8::gemm_phase<pg8::EpiIn, pg8::StaticOrder, true, true>(lds, g, S, E);
    }
    SEAM(1);
    if (IN(2)) { phase_2a(lds, args, lane, wave);
        if (!ENG_S) { for (size_t idx = (size_t)blockIdx.x * 512 + tid; idx < (size_t)M * 1536; idx += (size_t)G * 512) conv_act_elem((const bf16*)(ws + WS_XBC), args.in[4], args.in[9], args.in[10], (bf16*)(ws + 204 * MiB), idx); } }
    SEAM(2);
    if (IN(3)) { phase_2b(args, tid); }
    SEAM(3);
    if (IN(4)) { phase_2c(lds, args, lane, wave);
        LAS float* red = (LAS float*)lds;
        if (!ENG_H) { __syncthreads();
            for (int grp = blockIdx.x; grp < 16 + 256; grp += G)
                simple_hgrn(red + 2 * (tid >> 7), grp * 4 + (tid >> 7), tid & 127, (bf16*)(ws + WS_QZ), (const unsigned short*)(ws + WS_F), (const bf16*)(args.out) + (size_t)M * 1024, (const bf16*)(args.out), args.in[2], args.in[8], args.out + O_HGP, args.out + O_HGS);
            __syncthreads(); }
        if (!ENG_S) { __syncthreads();
            for (int u = blockIdx.x; u < 16 + 256; u += G)
                simple_ssd(red + 16, u, (bf16*)(ws + WS_QZ), (const bf16*)(ws + 204 * MiB), (const float*)(ws + WS_DT), args.in[3], args.in[12], args.in[13], args.in[14], args.out + O_SSP, args.out + O_SSS);
            __syncthreads(); }
    }
    SEAM(4);
    if (IN(5) && ENG_S) { phase_2d(args, tid); }
    SEAM(5);
    if (IN(6)) {
        {
            pg8::Gemm g{(const bf16*)(ws + WS_QZ), (const bf16*)(ws + WS_WOUT), M, D, DMIX / 4, DMIX}; pg8::SplitOrder S{G, (int)blockIdx.x};
            pg8::EpiDownSplit E{(float*)(ws + WS_PART)};
            pg8::gemm_phase<pg8::EpiDownSplit, pg8::SplitOrder, true, true>(lds, g, S, E);
        }
        pg8::Gemm g{(const bf16*)(ws + WS_QZ), (const bf16*)(ws + WS_WOUT), MP, D, DMIX, DMIX}; pg8::StaticOrder S; S.init(MP, D, G, (int)blockIdx.x);
        pg8::EpiOut E{args.in[0], args.in[1], args.out + O_Y, (bf16*)(ws + WS_XG), args.in[16], (float*)(ws + WS_RSS1)};
        pg8::gemm_phase<pg8::EpiOut, pg8::StaticOrder, true, true>(lds, g, S, E);
        xcd_barrier(bar);
        p3_finish_samples(args, lane, wave);
    }
    SEAM(6);
    if (IN(7)) {
        pg8::Gemm g{(const bf16*)(ws + WS_XG), (const bf16*)(ws + WS_WUP), M, FF, D, D}; pg8::StaticOrder S; S.init(M, FF, G, (int)blockIdx.x);
        pg8::EpiUp E{(bf16*)(ws + WS_U), (const float*)(ws + WS_RSS1)};
        pg8::gemm_phase<pg8::EpiUp, pg8::StaticOrder, true, true>(lds, g, S, E);
    }
    SEAM(7);
    if (IN(8)) {
        {
            pg8::Gemm g{(const bf16*)(ws + WS_U), (const bf16*)(ws + WS_WDN), M, D, FF / 4, FF}; pg8::SplitOrder S{G, (int)blockIdx.x};
            pg8::EpiDownSplit E{(float*)(ws + WS_PART)};
            pg8::gemm_phase<pg8::EpiDownSplit, pg8::SplitOrder, true, true>(lds, g, S, E);
        }
        pg8::Gemm g{(const bf16*)(ws + WS_U), (const bf16*)(ws + WS_WDN), MP, D, FF, FF}; pg8::StaticOrder S; S.init(MP, D, G, (int)blockIdx.x);
        pg8::EpiDown E{args.out + O_Y};
        pg8::gemm_phase<pg8::EpiDown, pg8::StaticOrder, true, true>(lds, g, S, E);
    }
    SEAM(8);
    if (IN(9)) p6_final(args, lane, wave);
#undef IN
#undef SEAM
}
extern "C" void kernel_launch(void* const* d_in, const int* in_sizes, int n_in, void* d_out, int out_size, void* d_ws, size_t ws_size, hipStream_t stream) {
    static int grid = 0;
    if (grid == 0) {
        int dev = 0, cus = 0, per_cu = 0;
        (void)hipGetDevice(&dev); (void)hipDeviceGetAttribute(&cus, hipDeviceAttributeMultiprocessorCount, dev);
        if (hipFuncSetAttribute((const void*)mega, hipFuncAttributeMaxDynamicSharedMemorySize, LDS_BYTES) != hipSuccess) { fprintf(stderr, "hipFuncSetAttribute failed\n"); grid = -1; return; }
        if (n_in != 20 || out_size != (int)O_END || ws_size < WS_END) { fprintf(stderr, "kernel_launch: unexpected sizes n_in %d out %d ws %zu\n", n_in, out_size, ws_size); grid = -1; return; }
        if (hipOccupancyMaxActiveBlocksPerMultiprocessor(&per_cu, (const void*)mega, 512, LDS_BYTES) != hipSuccess || per_cu < 1) { fprintf(stderr, "occupancy query failed (%d)\n", per_cu); grid = -1; return; }
        grid = (cus > 0 ? cus : 256) * 1;
    }
    if (grid < 0) return;
    Args a{};
    for (int i = 0; i < 20; ++i) a.in[i] = (const float*)d_in[i];
    a.out = (float*)d_out; a.ws = (unsigned char*)d_ws; a.ph_lo = 0; a.ph_hi = 10;
    if (hipMemsetAsync((char*)d_ws + WS_BAR, 0, 16384, stream) != hipSuccess) { fprintf(stderr, "memset failed\n"); return; }
    void* kargs[] = {&a};
    hipError_t e = hipLaunchCooperativeKernel((const void*)mega, dim3(grid), dim3(512), kargs, LDS_BYTES, stream);
    if (e != hipSuccess) fprintf(stderr, "cooperative launch failed: %s (grid %d)\n", hipGetErrorString(e), grid);
}
```

```cpp
#define ENG_H 1
#define ENG_S 1
#include <hip/hip_runtime.h>
#include <cstdio>
#include <cstdint>
namespace pg8 {
#define PG8_LAS __attribute__((address_space(3)))
typedef unsigned short bf16_t;
typedef short bf16x8 __attribute__((ext_vector_type(8)));
typedef float f32x4 __attribute__((ext_vector_type(4)));
typedef unsigned u32x4 __attribute__((ext_vector_type(4)));
constexpr int BM = 256, BK = 64, HALF = 128, HTB = HALF * BK * 2  , STAGE_BYTES = 8 * HTB, NXCD = 8, WGM = 8;

__host__ __device__ __forceinline__ int lds_byte(int r, int c) { const int st = (r >> 4) * 2 + (c >> 5), rr = r & 15, cc = c & 31, ob = rr * 64 + cc * 2; return st * 1024 + (ob ^ (((ob >> 9) & 1) << 5)); }
__host__ __device__ __forceinline__ void stage_rc(int b, int& R, int& C) { const int st = b / 1024, sb = b % 1024, swz = sb ^ (((sb >> 9) & 1) << 5); R = (st >> 1) * 16 + swz / 64; C = (st & 1) * 32 + (swz % 64) / 2; }
__host__ __device__ __forceinline__ int perm32(int rho) { const int n = rho >> 4, i = rho & 15; return 8 * (i >> 2) + 4 * n + (i & 3); }

struct Unit { int pm, pn, ks; };
struct Gemm { const bf16_t* A; const bf16_t* Bt; int M, N, K, ld; };

struct StaticOrder {
    int nM, nN, nwg, G, c;
    __host__ __device__ void init(int M, int N, int G_, int c_) { nM = M / BM; nN = N / BM; nwg = nM * nN; G = G_; c = c_; }
    __host__ __device__ bool next(int i, Unit& u) const {
        const long L = (long)i * G + c; if (L >= nwg) return false;
        int wgid = (int)L; { const int q = nwg / NXCD, r = nwg % NXCD, xcd = wgid % NXCD, off = wgid / NXCD; wgid = (xcd < r ? xcd * (q + 1) : r * (q + 1) + (xcd - r) * q) + off; }
        const int nig = WGM * nN, gid = wgid / nig, fm = gid * WGM, gsz = (nM - fm) < WGM ? (nM - fm) : WGM;
        u.pm = fm + ((wgid % nig) % gsz); u.pn = (wgid % nig) / gsz; u.ks = 0; return true;
    }
    __device__ __forceinline__ void a_ready(const Unit&) const {}
    __device__ __forceinline__ void done(const Unit&) const {}
};

__device__ __forceinline__ unsigned cvt_pk_bf16(float lo, float hi) { unsigned r; asm volatile("v_cvt_pk_bf16_f32 %0, %1, %2" : "=v"(r) : "v"(lo), "v"(hi)); return r; }
__device__ __forceinline__ unsigned pk_f16(float lo, float hi) { _Float16 a = (_Float16)lo, b = (_Float16)hi; return (unsigned)__builtin_bit_cast(unsigned short, a) | ((unsigned)__builtin_bit_cast(unsigned short, b) << 16); }
__device__ __forceinline__ float silu_f(float x) { return x * __builtin_amdgcn_rcpf(1.0f + __expf(-x)); }
typedef unsigned u32x2 __attribute__((ext_vector_type(2)));
constexpr int MP_ROWS = 16384;

struct EpiIn {
    static constexpr bool PERM = true, AFTER_DRAIN = false;
    bf16_t* QZ; bf16_t* F; bf16_t* I; bf16_t* G; bf16_t* XBC; const float* LB; float* cvp; float* cvs;
    __device__ __forceinline__ void operator()(const f32x4 (&acc)[2][2][4][2], const Unit& u, int wr, int wc, int fr, int fq) const {
        const int pn = u.pn, row0 = u.pm * BM + wr * 64 + fr, cl = wc * 32 + 8 * fq;
        int reg, ldc, colt; bf16_t* base;
        if (pn < 4)       { base = QZ;        ldc = 2048; colt = pn * 256;        reg = 0; }
        else if (pn < 8)  { base = F;         ldc = 1024; colt = (pn - 4) * 256;  reg = 1; }
        else if (pn < 12) { base = I;         ldc = 1024; colt = (pn - 8) * 256;  reg = 0; }
        else if (pn < 16) { base = G;         ldc = 1024; colt = (pn - 12) * 256; reg = 2; }
        else if (pn < 20) { base = QZ + 1024; ldc = 2048; colt = (pn - 16) * 256; reg = 2; }
        else              { base = XBC;       ldc = 1536; colt = (pn - 20) * 256; reg = 3; }
        f32x4 lb[2][2];
        if (reg == 1) {
#pragma unroll
            for (int bj = 0; bj < 2; ++bj)
#pragma unroll
                for (int n = 0; n < 2; ++n) lb[bj][n] = *(const f32x4*)(LB + colt + cl + bj * HALF + 4 * n);
        }
#pragma unroll
        for (int ai = 0; ai < 2; ++ai)
#pragma unroll
            for (int m = 0; m < 4; ++m) {
                const int row = row0 + ai * HALF + m * 16;
                bf16_t* rowp = base + (size_t)row * ldc + colt + cl;
                float* cdst = nullptr;
                if (reg == 3) {
                    if (row < MP_ROWS) { const int t = row & 2047; if (t >= 2045) cdst = cvp + (size_t)((row >> 11) * 3 + (t - 2045)) * 1536 + colt + cl; }
                    else { const int r = row - MP_ROWS, t = r & 7; if (t >= 5) cdst = cvs + (size_t)((r >> 3) * 3 + (t - 5)) * 1536 + colt + cl; }
                }
#pragma unroll
                for (int bj = 0; bj < 2; ++bj) {
                    f32x4 v0 = acc[ai][bj][m][0], v1 = acc[ai][bj][m][1];
                    u32x4 w;
                    if (reg == 1) {
                        f32x4 l0 = lb[bj][0], l1 = lb[bj][1];
#pragma unroll
                        for (int e = 0; e < 4; ++e) {
                            float s0 = __builtin_amdgcn_rcpf(1.0f + __expf(-v0[e])), s1 = __builtin_amdgcn_rcpf(1.0f + __expf(-v1[e]));
                            v0[e] = __logf(l0[e] + (1.0f - l0[e]) * s0); v1[e] = __logf(l1[e] + (1.0f - l1[e]) * s1);
                        }
                        w.x = pk_f16(v0[0], v0[1]); w.y = pk_f16(v0[2], v0[3]); w.z = pk_f16(v1[0], v1[1]); w.w = pk_f16(v1[2], v1[3]);
                    } else {
                        if (reg == 2) {
#pragma unroll
                            for (int e = 0; e < 4; ++e) { v0[e] = silu_f(v0[e]); v1[e] = silu_f(v1[e]); }
                        }
                        if (reg == 3 && cdst) { *(f32x4*)(cdst + bj * HALF) = v0; *(f32x4*)(cdst + bj * HALF + 4) = v1; }
                        w.x = cvt_pk_bf16(v0[0], v0[1]); w.y = cvt_pk_bf16(v0[2], v0[3]); w.z = cvt_pk_bf16(v1[0], v1[1]); w.w = cvt_pk_bf16(v1[2], v1[3]);
                    }
                    *(u32x4*)(rowp + bj * HALF) = w;
                }
            }
    }
};

struct EpiOut {
    static constexpr bool PERM = false, AFTER_DRAIN = false;
    const float* xp; const float* xs; float* X1; bf16_t* XG; const float* ln2; float* rowss;
    __device__ __forceinline__ void operator()(const f32x4 (&acc)[2][2][4][2], const Unit& u, int wr, int wc, int fr, int fq) const {
        const int row0 = u.pm * BM + wr * 64 + fr, col0 = u.pn * BM + wc * 32 + 4 * fq;
        f32x4 gn[2][2];
#pragma unroll
        for (int bj = 0; bj < 2; ++bj)
#pragma unroll
            for (int n = 0; n < 2; ++n) gn[bj][n] = *(const f32x4*)(ln2 + col0 + bj * HALF + n * 16);
#pragma unroll
        for (int ai = 0; ai < 2; ++ai)
#pragma unroll
            for (int m = 0; m < 4; ++m) {
                const int row = row0 + ai * HALF + m * 16;
                const float* xin = (row < MP_ROWS) ? xp + (size_t)row * 1024 : xs + (size_t)(row - MP_ROWS) * 1024;
                float ss = 0.f;
#pragma unroll
                for (int bj = 0; bj < 2; ++bj)
#pragma unroll
                    for (int n = 0; n < 2; ++n) {
                        const int col = col0 + bj * HALF + n * 16;
                        const f32x4 v = *(const f32x4*)(xin + col) + acc[ai][bj][m][n];
                        *(f32x4*)(X1 + (size_t)row * 1024 + col) = v;
                        ss += (v[0] * v[0] + v[1] * v[1]) + (v[2] * v[2] + v[3] * v[3]);
                        const f32x4 g = v * gn[bj][n]; u32x2 w; w.x = cvt_pk_bf16(g[0], g[1]); w.y = cvt_pk_bf16(g[2], g[3]);
                        *(u32x2*)(XG + (size_t)row * 1024 + col) = w;
                    }
                ss += __shfl_xor(ss, 16); ss += __shfl_xor(ss, 32);
                if (fq == 0) unsafeAtomicAdd(rowss + row, ss);
            }
    }
};

struct EpiUp {
    static constexpr bool PERM = true, AFTER_DRAIN = false;
    bf16_t* U; const float* rowss;
    __device__ __forceinline__ void operator()(const f32x4 (&acc)[2][2][4][2], const Unit& u, int wr, int wc, int fr, int fq) const {
        const int row0 = u.pm * BM + wr * 64 + fr, col0 = u.pn * BM + wc * 32 + 8 * fq;
#pragma unroll
        for (int ai = 0; ai < 2; ++ai)
#pragma unroll
            for (int m = 0; m < 4; ++m) {
                const int row = row0 + ai * HALF + m * 16;
                const float rs = __builtin_amdgcn_rsqf(rowss[row] * (1.0f / 1024.0f) + 1e-5f);
                bf16_t* rowp = U + (size_t)row * 4096 + col0;
#pragma unroll
                for (int bj = 0; bj < 2; ++bj) {
                    f32x4 v0 = acc[ai][bj][m][0] * rs, v1 = acc[ai][bj][m][1] * rs;
#pragma unroll
                    for (int e = 0; e < 4; ++e) { float a = fmaxf(v0[e], 0.f), b = fmaxf(v1[e], 0.f); v0[e] = a * a; v1[e] = b * b; }
                    u32x4 w; w.x = cvt_pk_bf16(v0[0], v0[1]); w.y = cvt_pk_bf16(v0[2], v0[3]); w.z = cvt_pk_bf16(v1[0], v1[1]); w.w = cvt_pk_bf16(v1[2], v1[3]);
                    *(u32x4*)(rowp + bj * HALF) = w;
                }
            }
    }
};

struct EpiDown {
    static constexpr bool PERM = false, AFTER_DRAIN = false;
    float* X1;
    __device__ __forceinline__ void operator()(const f32x4 (&acc)[2][2][4][2], const Unit& u, int wr, int wc, int fr, int fq) const {
        const int row0 = u.pm * BM + wr * 64 + fr, col0 = u.pn * BM + wc * 32 + 4 * fq;
#pragma unroll
        for (int ai = 0; ai < 2; ++ai)
#pragma unroll
            for (int m = 0; m < 4; ++m) {
                const int row = row0 + ai * HALF + m * 16;
#pragma unroll
                for (int bj = 0; bj < 2; ++bj)
#pragma unroll
                    for (int n = 0; n < 2; ++n) { float* p = X1 + (size_t)row * 1024 + col0 + bj * HALF + n * 16; *(f32x4*)p = *(const f32x4*)p + acc[ai][bj][m][n]; }
            }
    }
};
struct EpiDownSplit {
    static constexpr bool PERM = false, AFTER_DRAIN = false;
    float* PART;
    __device__ __forceinline__ void operator()(const f32x4 (&acc)[2][2][4][2], const Unit& u, int wr, int wc, int fr, int fq) const {
        const int row0 = (u.pm - 64) * BM + wr * 64 + fr, col0 = u.pn * BM + wc * 32 + 4 * fq;
        float* base = PART + (size_t)u.ks * 1024 * 1024;
#pragma unroll
        for (int ai = 0; ai < 2; ++ai)
#pragma unroll
            for (int m = 0; m < 4; ++m) {
                const int row = row0 + ai * HALF + m * 16;
#pragma unroll
                for (int bj = 0; bj < 2; ++bj)
#pragma unroll
                    for (int n = 0; n < 2; ++n) *(f32x4*)(base + (size_t)row * 1024 + col0 + bj * HALF + n * 16) = acc[ai][bj][m][n];
            }
    }
};
struct SplitOrder {
    int G, c;
    __device__ bool next(int i, Unit& u) const { const int t = i * G + c; if (t >= 64) return false; const int tile = t >> 2; u.pm = 64 + (tile >> 2); u.pn = tile & 3; u.ks = t & 3; return true; }
    __device__ __forceinline__ void a_ready(const Unit&) const {}
    __device__ __forceinline__ void done(const Unit&) const {}
};

template <class Epi, class Sched, bool ALIGN_EPI = false, bool SP2 = false>
__device__ __forceinline__ void gemm_phase(PG8_LAS unsigned char* lds, const Gemm g, const Sched& S, const Epi& E) {
    int tid_ = threadIdx.x; asm volatile("" : "+v"(tid_));
    const int tid = tid_, wid = __builtin_amdgcn_readfirstlane(tid >> 6), lane = tid & 63, wr = wid >> 2, wc = wid & 3, fr = lane & 15, fq = lane >> 4;
    const int K = g.ld, nt = g.K / BK;
    unsigned voffA[2], voffB[2];
#pragma unroll
    for (int i = 0; i < 2; ++i) { int R, C; stage_rc(tid * 16 + i * 8192, R, C); const int Rb = Epi::PERM ? ((R & ~31) + perm32(R & 31)) : R;
        voffA[i] = (unsigned)(R * K + C) * 2u; voffB[i] = (unsigned)(Rb * K + C) * 2u; }
    const size_t kstep = (size_t)(BK * 2);
    const size_t hstep = (size_t)HALF * K * 2;
    const size_t tstep = 2 * hstep;
    const unsigned ldsw = (unsigned)wid * 1024u;
    const int aoff = lds_byte(wr * 64 + fr, fq * 8), boff = lds_byte(wc * 32 + fr, fq * 8);
#define PG8_SA(b, h) (((b) * 2 + (h)) * HTB)
#define PG8_SB(b, h) ((4 + (b) * 2 + (h)) * HTB)
#define PG8_STAGE(bufoff, gbase, voff) do { _Pragma("unroll") for (int _i = 0; _i < 2; ++_i) \
        __builtin_amdgcn_global_load_lds((const unsigned*)((const char*)(gbase) + (voff)[_i]), (PG8_LAS unsigned*)(lds + (bufoff) + ldsw + _i * 8192), 16, 0, 0); } while (0)
#define PG8_LDA(dst, b, h) do { _Pragma("unroll") for (int m = 0; m < 4; ++m) _Pragma("unroll") for (int k = 0; k < 2; ++k) dst[m][k] = *(const PG8_LAS bf16x8*)(lds + PG8_SA(b, h) + aoff + m * 2048 + k * 1024); } while (0)
#define PG8_LDB(dst, b, h) do { _Pragma("unroll") for (int n = 0; n < 2; ++n) _Pragma("unroll") for (int k = 0; k < 2; ++k) dst[n][k] = *(const PG8_LAS bf16x8*)(lds + PG8_SB(b, h) + boff + n * 2048 + k * 1024); } while (0)
#define PG8_MMA(ai, bj, At, Bt) do { __builtin_amdgcn_s_setprio(1); _Pragma("unroll") for (int m = 0; m < 4; ++m) _Pragma("unroll") for (int n = 0; n < 2; ++n) _Pragma("unroll") for (int k = 0; k < 2; ++k) \
        acc[ai][bj][m][n] = __builtin_amdgcn_mfma_f32_16x16x32_bf16(Bt[n][k], At[m][k], acc[ai][bj][m][n], 0, 0, 0); __builtin_amdgcn_s_setprio(0); } while (0)
#define PG8_WAIT_V(n) asm volatile("s_waitcnt vmcnt(" #n ")" ::: "memory")
#define PG8_WAIT_L(n) asm volatile("s_waitcnt lgkmcnt(" #n ")" ::: "memory")
#define PG8_BAR __builtin_amdgcn_s_barrier()
#define PG8_SCHED __builtin_amdgcn_sched_barrier(0)
    Unit cur, nxt; int ui = 0;
    if (!S.next(0, cur)) return;
    f32x4 acc[2][2][4][2];
#pragma unroll
    for (int a = 0; a < 2; ++a)
#pragma unroll
        for (int b = 0; b < 2; ++b)
#pragma unroll
            for (int m = 0; m < 4; ++m)
#pragma unroll
                for (int n = 0; n < 2; ++n) acc[a][b][m][n] = (f32x4){0.f, 0.f, 0.f, 0.f};
    bf16x8 At[4][2], B0[2][2], B1[2][2];
    const size_t sstep = (size_t)g.K * 2;
    const char* cA = (const char*)g.A + (size_t)cur.pm * tstep + (size_t)cur.ks * sstep; const char* cB = (const char*)g.Bt + (size_t)cur.pn * tstep + (size_t)cur.ks * sstep;
    S.a_ready(cur);
    if constexpr (SP2) {
        PG8_STAGE(PG8_SB(0, 0), cB, voffB); PG8_STAGE(PG8_SB(0, 1), cB + hstep, voffB); PG8_STAGE(PG8_SA(0, 0), cA, voffA); PG8_STAGE(PG8_SA(0, 1), cA + hstep, voffA);
        if (wr == 1) PG8_BAR;
        PG8_WAIT_V(2); PG8_BAR;
        PG8_STAGE(PG8_SB(1, 0), cB + kstep, voffB); PG8_STAGE(PG8_SA(1, 0), cA + kstep, voffA); PG8_STAGE(PG8_SB(1, 1), cB + hstep + kstep, voffB);
        PG8_WAIT_V(6); PG8_BAR;
    } else {
        PG8_STAGE(PG8_SB(0, 0), cB, voffB); PG8_STAGE(PG8_SA(0, 0), cA, voffA); PG8_STAGE(PG8_SB(0, 1), cB + hstep, voffB); PG8_STAGE(PG8_SA(0, 1), cA + hstep, voffA);
        if (wr == 1) PG8_BAR;
        PG8_WAIT_V(4); PG8_BAR;
        PG8_STAGE(PG8_SB(1, 0), cB + kstep, voffB); PG8_STAGE(PG8_SA(1, 0), cA + kstep, voffA); PG8_STAGE(PG8_SB(1, 1), cB + hstep + kstep, voffB);
        PG8_WAIT_V(6); PG8_BAR;
    }
    for (;;) {
        const bool has_next = S.next(ui + 1, nxt);
        const char* nA = has_next ? (const char*)g.A + (size_t)nxt.pm * tstep + (size_t)nxt.ks * sstep : cA; const char* nB = has_next ? (const char*)g.Bt + (size_t)nxt.pn * tstep + (size_t)nxt.ks * sstep : cB;
        for (int t = 0; t < nt; t += 2) {
            const bool last = (t == nt - 2);
            const char* a1 = cA + (size_t)(t + 1) * kstep;
            const char* a2 = last ? nA : cA + (size_t)(t + 2) * kstep; const char* b2 = last ? nB : cB + (size_t)(t + 2) * kstep;
            const char* a3 = a2 + kstep; const char* b3 = b2 + kstep;
            if (last && has_next) S.a_ready(nxt);
            if constexpr (SP2) {
            PG8_LDB(B0, 0, 0); PG8_LDB(B1, 0, 1); PG8_SCHED; PG8_LDA(At, 0, 0); PG8_STAGE(PG8_SA(1, 1), a1 + hstep, voffA);
            PG8_WAIT_V(8); PG8_WAIT_L(0); PG8_BAR; PG8_MMA(0, 0, At, B0); PG8_MMA(0, 1, At, B1); PG8_BAR; PG8_SCHED;
            PG8_LDA(At, 0, 1); PG8_STAGE(PG8_SB(0, 0), b2, voffB); PG8_STAGE(PG8_SB(0, 1), b2 + hstep, voffB); PG8_STAGE(PG8_SA(0, 0), a2, voffA);
            PG8_WAIT_V(8); PG8_WAIT_L(0); PG8_BAR; PG8_MMA(1, 0, At, B0); PG8_MMA(1, 1, At, B1); PG8_BAR; PG8_SCHED;
            PG8_LDB(B0, 1, 0); PG8_LDB(B1, 1, 1); PG8_SCHED; PG8_LDA(At, 1, 0); PG8_STAGE(PG8_SA(0, 1), a2 + hstep, voffA);
            PG8_WAIT_V(8); PG8_WAIT_L(0); PG8_BAR; PG8_MMA(0, 0, At, B0); PG8_MMA(0, 1, At, B1); PG8_BAR; PG8_SCHED;
            PG8_LDA(At, 1, 1); PG8_STAGE(PG8_SB(1, 0), b3, voffB); PG8_STAGE(PG8_SB(1, 1), b3 + hstep, voffB); PG8_STAGE(PG8_SA(1, 0), a3, voffA);
            PG8_WAIT_V(8); PG8_WAIT_L(0); PG8_BAR; PG8_MMA(1, 0, At, B0); PG8_MMA(1, 1, At, B1); PG8_BAR; PG8_SCHED;
            } else {
            PG8_LDB(B0, 0, 0); PG8_SCHED; PG8_LDA(At, 0, 0); PG8_STAGE(PG8_SA(1, 1), a1 + hstep, voffA);
            PG8_WAIT_L(8); PG8_BAR; PG8_WAIT_L(0); PG8_MMA(0, 0, At, B0); PG8_BAR; PG8_SCHED;
            PG8_LDB(B1, 0, 1); PG8_STAGE(PG8_SB(0, 0), b2, voffB);
            PG8_BAR; PG8_WAIT_L(0); PG8_MMA(0, 1, At, B1); PG8_BAR;
            PG8_LDA(At, 0, 1); PG8_STAGE(PG8_SA(0, 0), a2, voffA);
            PG8_BAR; PG8_WAIT_L(0); PG8_MMA(1, 0, At, B0); PG8_BAR; PG8_SCHED;
            PG8_STAGE(PG8_SB(0, 1), b2 + hstep, voffB);
            PG8_WAIT_V(6); PG8_BAR; PG8_MMA(1, 1, At, B1); PG8_BAR;
            PG8_LDB(B0, 1, 0); PG8_SCHED; PG8_LDA(At, 1, 0); PG8_STAGE(PG8_SA(0, 1), a2 + hstep, voffA);
            PG8_WAIT_L(8); PG8_BAR; PG8_WAIT_L(0); PG8_MMA(0, 0, At, B0); PG8_BAR; PG8_SCHED;
            PG8_LDB(B1, 1, 1); PG8_STAGE(PG8_SB(1, 0), b3, voffB);
            PG8_BAR; PG8_WAIT_L(0); PG8_MMA(0, 1, At, B1); PG8_BAR;
            PG8_LDA(At, 1, 1); PG8_STAGE(PG8_SA(1, 0), a3, voffA);
            PG8_BAR; PG8_WAIT_L(0); PG8_MMA(1, 0, At, B0); PG8_BAR; PG8_SCHED;
            PG8_STAGE(PG8_SB(1, 1), b3 + hstep, voffB);
            PG8_WAIT_V(6); PG8_BAR; PG8_MMA(1, 1, At, B1); PG8_BAR;
            }
        }
        if constexpr (ALIGN_EPI) { if (wr == 0) PG8_BAR; }
        if constexpr (!Epi::AFTER_DRAIN) { E(acc, cur, wr, wc, fr, fq); S.done(cur); }
        if (!has_next) break;
#pragma unroll
        for (int a = 0; a < 2; ++a)
#pragma unroll
            for (int b = 0; b < 2; ++b)
#pragma unroll
                for (int m = 0; m < 4; ++m)
#pragma unroll
                    for (int n = 0; n < 2; ++n) acc[a][b][m][n] = (f32x4){0.f, 0.f, 0.f, 0.f};
        cur = nxt; cA = nA; cB = nB; ++ui;
        if constexpr (ALIGN_EPI) { if (wr == 1) PG8_BAR; }
    }
    PG8_WAIT_V(0);
    if constexpr (!ALIGN_EPI) { if (wr == 0) PG8_BAR; }
    PG8_BAR;
    if constexpr (Epi::AFTER_DRAIN) { E.fused(acc, cur, wr, wc, fr, fq, lds, wid, lane); S.done(cur); }
#undef PG8_SA
#undef PG8_SB
#undef PG8_STAGE
#undef PG8_LDA
#undef PG8_LDB
#undef PG8_MMA
#undef PG8_WAIT_V
#undef PG8_WAIT_L
#undef PG8_BAR
#undef PG8_SCHED
}
}
#include <hip/hip_cooperative_groups.h>
namespace cg = cooperative_groups;
#define LAS __attribute__((address_space(3)))
typedef unsigned short bf16;
typedef pg8::f32x4 f32x4;
typedef pg8::u32x4 u32x4;
typedef pg8::u32x2 u32x2;
typedef float f32x2 __attribute__((ext_vector_type(2)));
typedef pg8::bf16x8 bf16x8;
using pg8::cvt_pk_bf16;
using pg8::silu_f;
constexpr int NWAVES = 8;
constexpr int M = 17408, MP = 16384, MS = 1024, D = 1024, NIN = 6656, LDWIN = 6672, DMIX = 2048, FF = 4096;
constexpr float EPS = 1e-5f;
constexpr size_t MiB = 1u << 20;
constexpr size_t WS_PART = 236 * MiB;
constexpr size_t WS_HD = 1572864, WS_SD = 1835008, WS_SSQ = 1884160;
constexpr size_t WS_DT = 0, WS_RSS1 = 1114112, WS_RSS2 = WS_RSS1 + 69632, WS_LB = WS_RSS2 + 69632;
constexpr size_t WS_WIN = 2 * MiB, WS_WOUT = 15 * MiB, WS_WUP = 19 * MiB, WS_WDN = 27 * MiB, WS_F = 35 * MiB, WS_XG = 35 * MiB, WS_QZ = 69 * MiB, WS_XBC = 137 * MiB;
constexpr size_t WS_HSEG = 188 * MiB, WS_SSEG = 204 * MiB, WS_XN = 188 * MiB, WS_U = 69 * MiB, WS_XBA = 188 * MiB, WS_END = 252 * MiB;
constexpr size_t O_Y = 0, O_HGP = 17825792, O_HGS = 18874368, O_SSP = 35651584, O_SSS = 36700160, O_CVP = 53477376, O_CVS = 53514240, O_END = 54104064;
constexpr int LDS_BYTES = 147456;

__device__ __forceinline__ float wave_sum(float v) {
#pragma unroll
    for (int o = 1; o < 64; o <<= 1) v += __shfl_xor(v, o);
    return v;
}
__device__ __forceinline__ float bf2f(bf16 b) { return __uint_as_float((unsigned)b << 16); }
__device__ __forceinline__ float h2f(unsigned short h) { return (float)__builtin_bit_cast(_Float16, h); }

#define XB_TMO      128
#define XB_XCNT(j)  (256  + 64 * (j))
#define XB_XSUB(j)  (1280 + 64 * (j))
#define XB_XGEN(j)  (2304 + 64 * (j))
#define XB_TOP      3328
#define XB_TOPGEN   3392
#define XCD_BAR_WORDS 3456
#define XB_SPIN_CAP (1u << 18)

__device__ __forceinline__ unsigned xb_ld(unsigned* p)              { return __hip_atomic_load(p, __ATOMIC_RELAXED, __HIP_MEMORY_SCOPE_AGENT); }
__device__ __forceinline__ unsigned xb_add(unsigned* p, unsigned v) { return __hip_atomic_fetch_add(p, v, __ATOMIC_RELAXED, __HIP_MEMORY_SCOPE_AGENT); }
__device__ __forceinline__ unsigned xb_xcc_id() { return (unsigned)__builtin_amdgcn_s_getreg((3 << 11) | 20) & 0xFu; }
#define XB_SPIN(cond, bar) do { unsigned _sp = 0; while (cond) { __builtin_amdgcn_s_sleep(1); \
    if ((++_sp & 255u) == 0u) { if (xb_ld(&(bar)[XB_TMO])) break; if (_sp > XB_SPIN_CAP) { atomicAdd(&(bar)[XB_TMO], 1u); break; } } } } while (0)

struct XcdBarrier {
    unsigned* bar; unsigned x;
    volatile LAS unsigned* st;
};

__device__ __forceinline__ XcdBarrier xcd_barrier_post(unsigned* bar, volatile LAS unsigned* st) {
    XcdBarrier b; b.bar = bar; b.x = xb_xcc_id(); b.st = st;
    if (threadIdx.x == 0) (void)xb_add(&bar[XB_XCNT(b.x)], 1u);
    return b;
}
__device__ __forceinline__ void xcd_barrier_complete(unsigned* bar, unsigned x, unsigned& nloc, unsigned& nx) {
    const unsigned G = gridDim.x * gridDim.y * gridDim.z;
    unsigned sum, cnt, mine, sp = 0u;
    for (;;) {
        sum = 0u; cnt = 0u; mine = 0u;
#pragma unroll
        for (unsigned j = 0; j < 16; ++j) { const unsigned c = xb_ld(&bar[XB_XCNT(j)]); sum += c; cnt += (c > 0u) ? 1u : 0u; mine = (j == x) ? c : mine; }
        if (sum == G) break;
        __builtin_amdgcn_s_sleep(1);
        if ((++sp & 255u) == 0u) { if (xb_ld(&bar[XB_TMO])) break; if (sp > XB_SPIN_CAP) { atomicAdd(&bar[XB_TMO], 1u); break; } }
    }
    nloc = mine > 0u ? mine : 1u; nx = cnt > 0u ? cnt : 1u;
}

__device__ __forceinline__ void xcd_barrier(const XcdBarrier& b) {
    asm volatile("s_waitcnt vmcnt(0)" ::: "memory");
    __syncthreads();
    if (threadIdx.x == 0) {
        unsigned* bar = b.bar;
        __builtin_amdgcn_s_waitcnt(0);
        unsigned nloc = b.st[0], nx = b.st[1];
        if (nloc == 0u) { xcd_barrier_complete(bar, b.x, nloc, nx); b.st[0] = nloc; b.st[1] = nx; }
        const unsigned old = xb_add(&bar[XB_XSUB(b.x)], 1u);
        const unsigned gen = old / nloc;
        if (old + 1u == (gen + 1u) * nloc) {
            __builtin_amdgcn_fence(__ATOMIC_RELEASE, "agent");
            asm volatile("s_waitcnt vmcnt(0)" ::: "memory");
            const unsigned og = xb_add(&bar[XB_TOP], 1u);
            const unsigned tg = og / nx;
            if (og + 1u == (tg + 1u) * nx) xb_add(&bar[XB_TOPGEN], 1u);
            else XB_SPIN(xb_ld(&bar[XB_TOPGEN]) == tg, bar);
            __builtin_amdgcn_fence(__ATOMIC_ACQUIRE, "agent");
            xb_add(&bar[XB_XGEN(b.x)], 1u);
            asm volatile("s_waitcnt vmcnt(0)" ::: "memory");
        } else {
            XB_SPIN(xb_ld(&bar[XB_XGEN(b.x)]) == gen, bar);
            __builtin_amdgcn_fence(__ATOMIC_ACQUIRE, "agent");
            asm volatile("s_waitcnt vmcnt(0)" ::: "memory");
        }
    }
    __syncthreads();
}

constexpr size_t WS_BAR = 1310720;
struct Args { const float* in[20]; float* out; unsigned char* ws; int ph_lo, ph_hi; };

__device__ __forceinline__ void p0_transpose_item(const float* W, int ldw, int K, int nblk, bf16* WT, LAS float* scr, int item, int lane) {
    const int kb = item / nblk, nb = item % nblk, k0 = 64 * kb, n0 = 32 * nb;
#pragma unroll 8
    for (int i = 0; i < 32; ++i) { const int kk = 2 * i + (lane >> 5); scr[kk * 33 + (lane & 31)] = W[(size_t)(k0 + kk) * ldw + n0 + (lane & 31)]; }
    asm volatile("s_waitcnt lgkmcnt(0)" ::: "memory");
    const int c = lane & 7;
#pragma unroll
    for (int j = 0; j < 4; ++j) { const int n = (lane >> 3) + 8 * j; const LAS float* s = scr + (8 * c) * 33 + n;
        u32x4 o; o.x = cvt_pk_bf16(s[0 * 33], s[1 * 33]); o.y = cvt_pk_bf16(s[2 * 33], s[3 * 33]); o.z = cvt_pk_bf16(s[4 * 33], s[5 * 33]); o.w = cvt_pk_bf16(s[6 * 33], s[7 * 33]);
        *(u32x4*)(WT + (size_t)(n0 + n) * K + k0 + 8 * c) = o; }
    asm volatile("s_waitcnt lgkmcnt(0)" ::: "memory");
}

__device__ __forceinline__ void p0_prologue(const Args& a, LAS unsigned char* lds, int tid, int lane, int wave) {
    unsigned char* ws = a.ws;
    const int gw = blockIdx.x * NWAVES + wave, NGW = gridDim.x * NWAVES;
    const int gt = blockIdx.x * 512 + tid, NGT = gridDim.x * 512;
    { float* r1 = (float*)(ws + WS_RSS1); for (int i = gt; i < 2 * M; i += NGT) r1[i] = 0.f;
      float* sq = (float*)(ws + WS_SSQ); for (int i = gt; i < 2 * M; i += NGT) sq[i] = 0.f;
      float* lb = (float*)(ws + WS_LB); const float* lg = a.in[5];
      for (int i = gt; i < 1024; i += NGT) { const float l0 = lg[i], l1 = lg[1024 + i]; lb[i] = 1.0f / (1.0f + __expf(l1 - l0)); } }
    LAS f32x4* wdt = (LAS f32x4*)lds;
    for (int idx = tid; idx < 4096; idx += 512) { const int ln = idx & 63, c4 = (idx >> 6) & 3, ji = idx >> 8, j = ji >> 2, i = ji & 3, k = 256 * j + 4 * ln + i;
        wdt[idx] = *(const f32x4*)(a.in[7] + (size_t)k * LDWIN + NIN + 4 * c4); }
    __syncthreads();
    LAS float* scr = (LAS float*)(lds + 65536 + wave * 8448);
    constexpr int I_IN = (D / 64) * (NIN / 32), I_OUT = (DMIX / 64) * (D / 32), I_UP = (D / 64) * (FF / 32), I_DN = (FF / 64) * (D / 32);
    for (int it = gw; it < I_IN + I_OUT; it += NGW) {
        int r = it;
        if (r < I_IN) { p0_transpose_item(a.in[7], LDWIN, D, NIN / 32, (bf16*)(ws + WS_WIN), scr, r, lane); continue; } r -= I_IN;
        if (r < I_OUT) { p0_transpose_item(a.in[15], D, DMIX, D / 32, (bf16*)(ws + WS_WOUT), scr, r, lane); continue; } r -= I_OUT;
        if (r < I_UP) { p0_transpose_item(a.in[17], FF, D, FF / 32, (bf16*)(ws + WS_WUP), scr, r, lane); continue; } r -= I_UP;
        p0_transpose_item(a.in[18], D, FF, D / 32, (bf16*)(ws + WS_WDN), scr, r, lane);
    }
    bf16* XN = (bf16*)(ws + WS_XN); float* DT = (float*)(ws + WS_DT);
    f32x4 gl[4];
#pragma unroll
    for (int j = 0; j < 4; ++j) gl[j] = ((const f32x4*)a.in[6])[lane + 64 * j];
    const float dtb = a.in[11][lane & 15];
    for (int grp = gw; grp < M / 4; grp += NGW) {
        const int r0 = grp * 4;
        f32x4 v[4][4];
#pragma unroll
        for (int r = 0; r < 4; ++r) { const int row = r0 + r; const f32x4* xr = (const f32x4*)((row < MP) ? a.in[0] + (size_t)row * D : a.in[1] + (size_t)(row - MP) * D);
#pragma unroll
            for (int j = 0; j < 4; ++j) v[r][j] = xr[lane + 64 * j]; }
#pragma unroll
        for (int r = 0; r < 4; ++r) { float s = 0.f;
#pragma unroll
            for (int j = 0; j < 4; ++j) s += (v[r][j][0] * v[r][j][0] + v[r][j][1] * v[r][j][1]) + (v[r][j][2] * v[r][j][2] + v[r][j][3] * v[r][j][3]);
            const float rstd = __builtin_amdgcn_rsqf(wave_sum(s) * (1.0f / D) + EPS);
            u32x2* o8 = (u32x2*)(XN + (size_t)(r0 + r) * D);
#pragma unroll
            for (int j = 0; j < 4; ++j) { v[r][j] = v[r][j] * rstd * gl[j]; u32x2 w; w.x = cvt_pk_bf16(v[r][j][0], v[r][j][1]); w.y = cvt_pk_bf16(v[r][j][2], v[r][j][3]); o8[lane + 64 * j] = w; } }
        float ac[64];
#pragma unroll
        for (int i = 0; i < 64; ++i) ac[i] = 0.f;
#pragma unroll
        for (int j = 0; j < 4; ++j)
#pragma unroll
            for (int i = 0; i < 4; ++i)
#pragma unroll
                for (int c4 = 0; c4 < 4; ++c4) { const f32x4 w = wdt[((j * 4 + i) * 4 + c4) * 64 + lane];
#pragma unroll
                    for (int r = 0; r < 4; ++r) { const float hv = v[r][j][i];
                        ac[r * 16 + c4 * 4 + 0] += hv * w[0]; ac[r * 16 + c4 * 4 + 1] += hv * w[1]; ac[r * 16 + c4 * 4 + 2] += hv * w[2]; ac[r * 16 + c4 * 4 + 3] += hv * w[3]; } }
#pragma unroll
        for (int half = 32; half >= 1; half >>= 1) {
            const bool up = (lane & half) != 0;
#pragma unroll
            for (int i = 0; i < half; ++i) { const float send = up ? ac[i] : ac[i + half], keep = up ? ac[i + half] : ac[i]; ac[i] = keep + __shfl_xor(send, half); }
        }
        const float xr_ = ac[0] + dtb;
        DT[(size_t)r0 * 16 + lane] = fmaxf(xr_, 0.f) + log1pf(__expf(-fabsf(xr_)));
    }
}

__device__ __forceinline__ void p6_final(const Args& a, int lane, int wave) {
    float* Y = a.out + O_Y;
    const int gw = blockIdx.x * NWAVES + wave, NGW = gridDim.x * NWAVES;
    f32x4 gl[4];
#pragma unroll
    for (int j = 0; j < 4; ++j) gl[j] = ((const f32x4*)a.in[19])[lane + 64 * j];
    for (int row = gw; row < M; row += NGW) {
        f32x4* p = (f32x4*)(Y + (size_t)row * D); f32x4 v[4]; float ss = 0.f;
#pragma unroll
        for (int j = 0; j < 4; ++j) { v[j] = p[lane + 64 * j];
            if (row >= MP) { const f32x4* pp = (const f32x4*)((const float*)(a.ws + WS_PART) + (size_t)(row - MP) * D) + lane + 64 * j;
                v[j] = v[j] + ((pp[0] + pp[262144]) + (pp[524288] + pp[786432])); }
            ss += (v[j][0] * v[j][0] + v[j][1] * v[j][1]) + (v[j][2] * v[j][2] + v[j][3] * v[j][3]); }
        const float rs = __builtin_amdgcn_rsqf(wave_sum(ss) * (1.0f / D) + EPS);
#pragma unroll
        for (int j = 0; j < 4; ++j) p[lane + 64 * j] = v[j] * rs * gl[j];
    }
}


__device__ __forceinline__ void p3_finish_samples(const Args& a, int lane, int wave) {
    const int gw = blockIdx.x * NWAVES + wave, NGW = gridDim.x * NWAVES;
    f32x4 gl[4];
#pragma unroll
    for (int j = 0; j < 4; ++j) gl[j] = ((const f32x4*)a.in[16])[lane + 64 * j];
    for (int r = gw; r < MS; r += NGW) {
        const f32x4* xr = (const f32x4*)(a.in[1] + (size_t)r * D); const f32x4* pp = (const f32x4*)((const float*)(a.ws + WS_PART) + (size_t)r * D);
        f32x4* x1 = (f32x4*)(a.out + O_Y + (size_t)(MP + r) * D); u32x2* xg = (u32x2*)((bf16*)(a.ws + WS_XG) + (size_t)(MP + r) * D);
        float ss = 0.f;
#pragma unroll
        for (int j = 0; j < 4; ++j) { const int q = lane + 64 * j;
            const f32x4 v = xr[q] + ((pp[q] + pp[q + 262144]) + (pp[q + 524288] + pp[q + 786432]));
            x1[q] = v; ss += (v[0] * v[0] + v[1] * v[1]) + (v[2] * v[2] + v[3] * v[3]);
            const f32x4 g = v * gl[j]; u32x2 w; w.x = cvt_pk_bf16(g[0], g[1]); w.y = cvt_pk_bf16(g[2], g[3]); xg[q] = w; }
        ss = wave_sum(ss);
        if (lane == 0) ((float*)(a.ws + WS_RSS1))[MP + r] = ss;
    }
}

__device__ __forceinline__ void late_weight_copies(const Args& a, LAS unsigned char* lds, int lane, int wave) {
    if (blockIdx.x < 64 || gridDim.x <= 64) return;
    LAS float* scr = (LAS float*)(lds + 65536 + wave * 8448);
    const int gw = (blockIdx.x - 64) * NWAVES + wave, NGW = (gridDim.x - 64) * NWAVES;
    constexpr int I_UP = (D / 64) * (FF / 32), I_DN = (FF / 64) * (D / 32);
    for (int it = gw; it < I_UP + I_DN; it += NGW) {
        if (it < I_UP) p0_transpose_item(a.in[17], FF, D, FF / 32, (bf16*)(a.ws + WS_WUP), scr, it, lane);
        else p0_transpose_item(a.in[18], D, FF, D / 32, (bf16*)(a.ws + WS_WDN), scr, it - I_UP, lane);
    }
}
__device__ __forceinline__ void conv_act_elem(const bf16* XBC, const float* conv0, const float* cw, const float* cb, bf16* XBA, size_t idx) {
    const int row = (int)(idx / 1536), col = (int)(idx % 1536);
    float acc = cb[col];
#pragma unroll
    for (int j = 0; j < 4; ++j) { const int off = j - 3; float xv;
        if (row < MP) { const int t = row & 2047; xv = (t + off >= 0) ? bf2f(XBC[(size_t)(row + off) * 1536 + col]) : 0.f; }
        else { const int r = row - MP, b = r >> 3, t = r & 7; xv = (t + off >= 0) ? bf2f(XBC[(size_t)(row + off) * 1536 + col]) : conv0[(size_t)(b * 3 + (3 + t + off)) * 1536 + col]; }
        acc += cw[j * 1536 + col] * xv; }
    XBA[idx] = (bf16)(cvt_pk_bf16(silu_f(acc), 0.f) & 0xffffu);
}
__device__ __forceinline__ void simple_hgrn(LAS float* red, int u, int v, bf16* QZ, const unsigned short* F, const bf16* I, const bf16* G, const float* S0, const float* hgn, float* outP, float* outS) {
    const int lane = v & 63, wv = v >> 6;
    int row0, L, h; const float* s0 = nullptr; float* so;
    if (u < 64) { h = u & 7; row0 = (u >> 3) * 2048; L = 2048; so = outP + (size_t)u * 16384; }
    else { const int us = u - 64; h = us & 7; row0 = MP + (us >> 3) * 8; L = 8; s0 = S0 + (size_t)us * 16384; so = outS + (size_t)us * 16384; }
    float S[128];
#pragma unroll
    for (int k = 0; k < 128; ++k) S[k] = s0 ? s0[k * 128 + v] : 0.f;
    for (int t = 0; t < L; ++t) {
        const size_t row = row0 + t; const float vv = bf2f(I[row * 1024 + h * 128 + v]); float o = 0.f;
#pragma unroll
        for (int k = 0; k < 128; ++k) { const float f = __expf(h2f(F[row * 1024 + h * 128 + k])); S[k] = f * S[k] + (1.0f - f) * vv; o += S[k] * bf2f(QZ[row * 2048 + h * 128 + k]); }
        float ss = wave_sum(o * o); if (lane == 0) red[wv] = ss; __syncthreads(); ss = red[0] + red[1];
        const float res = o * rsqrtf(ss * (1.0f / 128.0f) + EPS) * hgn[h * 128 + v] * bf2f(G[row * 1024 + h * 128 + v]);
        __syncthreads();
        QZ[row * 2048 + h * 128 + v] = (bf16)(cvt_pk_bf16(res, 0.f) & 0xffffu);
    }
#pragma unroll
    for (int k = 0; k < 128; ++k) so[k * 128 + v] = S[k];
}
__device__ __forceinline__ void simple_ssd(LAS float* red, int u, bf16* QZ, const bf16* XBA, const float* DT, const float* S0, const float* a_log, const float* d_skip, const float* mnorm, float* outP, float* outS) {
    const int tid = threadIdx.x, lane = tid & 63, wv = tid >> 6, p = lane;
    int row0, L, b, g; const float* s0 = nullptr; float* so;
    if (u < 16) { b = u >> 1; g = u & 1; row0 = b * 2048; L = 2048; }
    else { const int us = u - 16; b = us >> 1; g = us & 1; row0 = MP + b * 8; L = 8; }
    const int h = g * 8 + wv, ch = h * 64 + p;
    if (u < 16) so = outP + ((size_t)(b * 16 + h) * 64 + p) * 128; else { s0 = S0 + ((size_t)(b * 16 + h) * 64 + p) * 128; so = outS + ((size_t)(b * 16 + h) * 64 + p) * 128; }
    float S[128];
#pragma unroll
    for (int n = 0; n < 128; ++n) S[n] = s0 ? s0[n] : 0.f;
    const float A = -__expf(a_log[h]), Dk = d_skip[h], gain = mnorm[ch];
    for (int t = 0; t < L; ++t) {
        const size_t row = row0 + t; const float dt = DT[row * 16 + h], xs = bf2f(XBA[row * 1536 + ch]), dec = __expf(dt * A), xdt = xs * dt; float y = 0.f;
        const bf16* Bp = XBA + row * 1536 + 1024 + g * 128; const bf16* Cp = XBA + row * 1536 + 1280 + g * 128;
#pragma unroll
        for (int n = 0; n < 128; ++n) { S[n] = dec * S[n] + xdt * bf2f(Bp[n]); y += S[n] * bf2f(Cp[n]); }
        y += Dk * xs; y *= bf2f(QZ[row * 2048 + 1024 + ch]);
        float ss = wave_sum(y * y); if (lane == 0) red[wv] = ss; __syncthreads();
        ss = ((red[0] + red[1]) + (red[2] + red[3])) + ((red[4] + red[5]) + (red[6] + red[7]));
        const float res = y * rsqrtf(ss * (1.0f / 512.0f) + EPS) * gain;
        __syncthreads();
        QZ[row * 2048 + 1024 + ch] = (bf16)(cvt_pk_bf16(res, 0.f) & 0xffffu);
    }
#pragma unroll
    for (int n = 0; n < 128; ++n) so[n] = S[n];
}
__device__ __forceinline__ unsigned pkbf(float lo, float hi) { unsigned r; asm("v_cvt_pk_bf16_f32 %0, %1, %2" : "=v"(r) : "v"(lo), "v"(hi)); return r; }
__device__ __forceinline__ bf16x8 pack8(f32x4 a, f32x4 b) { u32x4 w; w.x = pkbf(a[0], a[1]); w.y = pkbf(a[2], a[3]); w.z = pkbf(b[0], b[1]); w.w = pkbf(b[2], b[3]); return __builtin_bit_cast(bf16x8, w); }
__device__ __forceinline__ float lo16(unsigned u) { return __uint_as_float(u << 16); }
__device__ __forceinline__ float hi16(unsigned u) { return __uint_as_float(u & 0xffff0000u); }
__device__ __forceinline__ void st_sc1_8(void* p, u32x2 v) { __hip_atomic_store((unsigned long long*)p, (unsigned long long)v.x | ((unsigned long long)v.y << 32), __ATOMIC_RELAXED, __HIP_MEMORY_SCOPE_AGENT); }
__device__ __forceinline__ void st_sc1_16(void* p, u32x4 v) { asm volatile("global_store_dwordx4 %0, %1, off sc1\n\ts_nop 1" :: "v"(p), "v"(v) : "memory"); }
#define MFMA16(a, b, c) __builtin_amdgcn_mfma_f32_16x16x32_bf16((a), (b), (c), 0, 0, 0)
#define WG_BAR() do { asm volatile("s_waitcnt lgkmcnt(0)" ::: "memory"); __builtin_amdgcn_s_barrier(); asm volatile("" ::: "memory"); } while (0)
constexpr int E_QD = 0, E_KD = 8704, E_KET = 17408, E_VT = 27648, E_VTE = 68608, E_TOT = 109568, E_DEC = 113664, E_RED = 114176, E_CUM = 115200, E_DTV = 116224, E_TOTH = 117248;
constexpr int QP = 272, KP = 80;

struct GlaP {
    int row0, ntok, nch, seq_t0, head, half, samp_b;
    const float* Sinit; int init_lay;
    int nprev; const float* Dprev;
    float* Sout; int out_lay;
    float* Dout;
};

template <int MODE, bool OUT>
__device__ __forceinline__ void gla_unit(LAS unsigned char* lds, const GlaP P, const Args& args, int lane, int w) {
    constexpr int NV = MODE == 0 ? 1 : 2;
    const int fr = lane & 15, fq = lane >> 4;
    const int vbase = MODE == 0 ? 16 * w : 32 * w;
    const int hl = w >> 1;
    unsigned char* ws = args.ws;
    bf16* QZ = (bf16*)(ws + WS_QZ);
    const unsigned short* Fb = (const unsigned short*)(ws + WS_F);
    const bf16* Ib = (const bf16*)(args.out) + (size_t)M * 1024;
    const bf16* Gb = (const bf16*)(args.out);
    const bf16* XBC = (const bf16*)(ws + WS_XBC);
    const float* DT = (const float*)(ws + WS_DT);
    const int posoff = 2 * (8 * (w & 3) + 4 * (w >> 2));
    LAS float* TOT = (LAS float*)(lds + E_TOT); LAS float* DEC = (LAS float*)(lds + E_DEC); LAS float* RED = (LAS float*)(lds + E_RED);
    LAS float* CUM = (LAS float*)(lds + E_CUM); LAS float* DTV = (LAS float*)(lds + E_DTV); LAS float* TOTH = (LAS float*)(lds + E_TOTH);
    f32x4 S[8][NV];
    if (P.init_lay == 0) {
#pragma unroll
        for (int kt = 0; kt < 8; ++kt)
#pragma unroll
            for (int vt = 0; vt < NV; ++vt) S[kt][vt] = (f32x4){0.f, 0.f, 0.f, 0.f};
    } else if (P.init_lay == 2) {
        const f32x4* sp = (const f32x4*)P.Sinit;
#pragma unroll
        for (int kt = 0; kt < 8; ++kt)
#pragma unroll
            for (int vt = 0; vt < NV; ++vt) S[kt][vt] = sp[((w * 8 + kt) * NV + vt) * 64 + lane];
    } else {
        if constexpr (MODE == 0) {
#pragma unroll
            for (int kt = 0; kt < 8; ++kt)
#pragma unroll
                for (int r = 0; r < 4; ++r) S[kt][0][r] = P.Sinit[(size_t)(16 * kt + 4 * fq + r) * 128 + 16 * w + fr];
        } else {
            const float* sb = P.Sinit + (size_t)hl * 8192 + (size_t)(32 * (w & 1)) * 128;
#pragma unroll
            for (int kt = 0; kt < 8; ++kt)
#pragma unroll
                for (int vt = 0; vt < NV; ++vt) S[kt][vt] = *(const f32x4*)(sb + (size_t)(16 * vt + fr) * 128 + 16 * kt + 4 * fq);
        }
    }
    float slog0 = 0.f, slog1 = 0.f;
    const int hh = MODE == 0 ? P.head : 8 * P.head + 4 * P.half + hl;
    float A_h = 0.f, Dsk = 0.f;
    if constexpr (MODE == 1) { A_h = -__expf(args.in[12][hh]); Dsk = args.in[13][hh]; }

    unsigned rawq[4] = {0u, 0u, 0u, 0u}, rawf[4] = {0u, 0u, 0u, 0u}, rawv[4] = {0u, 0u, 0u, 0u};
#define HG_PREFETCH(cc_) do { if constexpr (MODE == 0) { _Pragma("unroll") for (int i_ = 0; i_ < 4; ++i_) { const int t_ = 32 * (cc_) + 4 * w + i_; \
        if (t_ < P.ntok) { const size_t row_ = (size_t)(P.row0 + t_); rawf[i_] = *(const unsigned*)(Fb + row_ * 1024 + hh * 128 + 2 * lane); rawv[i_] = *(const unsigned*)(Ib + row_ * 1024 + hh * 128 + 2 * lane); \
            rawq[i_] = OUT ? *(const unsigned*)(QZ + row_ * 2048 + hh * 128 + 2 * lane) : 0u; } \
        else { rawf[i_] = 0u; rawv[i_] = 0u; rawq[i_] = 0u; } } } } while (0)
    HG_PREFETCH(0);
    const bool usepf = MODE == 1 && P.samp_b < 0;
    unsigned pC[7] = {0u, 0u, 0u, 0u, 0u, 0u, 0u};
    unsigned pB[7] = {0u, 0u, 0u, 0u, 0u, 0u, 0u}, pX[2][7] = {{0u, 0u, 0u, 0u, 0u, 0u, 0u}, {0u, 0u, 0u, 0u, 0u, 0u, 0u}}; float pdt = 0.f;
#define SS_PREFETCH(cc_) do { if constexpr (MODE == 1) { if (usepf) { _Pragma("unroll") for (int j_ = 0; j_ < 7; ++j_) { const int tr_ = 32 * (cc_) + 4 * w - 3 + j_; \
        if (tr_ < P.ntok && tr_ + P.seq_t0 >= 0) { const bf16* rp_ = XBC + (size_t)(P.row0 + tr_) * 1536; pB[j_] = *(const unsigned*)(rp_ + 1024 + P.head * 128 + 2 * lnq); if (OUT) pC[j_] = *(const unsigned*)(rp_ + 1280 + P.head * 128 + 2 * lnq); \
            pX[0][j_] = *(const unsigned*)(rp_ + P.head * 512 + 256 * P.half + 2 * lnq); pX[1][j_] = *(const unsigned*)(rp_ + P.head * 512 + 256 * P.half + 128 + 2 * lnq); } \
        else { pB[j_] = 0u; pC[j_] = 0u; pX[0][j_] = 0u; pX[1][j_] = 0u; } } \
        { const int tk_ = 32 * (cc_) + (lnq & 31); pdt = (tk_ < P.ntok) ? DT[(size_t)(P.row0 + tk_) * 16 + hh] : 0.f; } } } } while (0)
    { int lnq = lane; asm volatile("" : "+v"(lnq)); SS_PREFETCH(0); }
    u32x2 gpre[2] = {{0u, 0u}, {0u, 0u}};
    for (int c = 0; c < P.nch; ++c) {
        const int tb = 32 * c + 4 * w;
        if constexpr (MODE == 0) {
            float q[4][2], lf[4][2], vv[4][2];
#pragma unroll
            for (int i = 0; i < 4; ++i) {
                lf[i][0] = h2f((unsigned short)(rawf[i] & 0xffffu)); lf[i][1] = h2f((unsigned short)(rawf[i] >> 16));
                vv[i][0] = lo16(rawv[i]); vv[i][1] = hi16(rawv[i]);
                q[i][0] = lo16(rawq[i]); q[i][1] = hi16(rawq[i]);
            }
            if (c + 1 < P.nch) HG_PREFETCH(c + 1);
            float cs[4][2];
#pragma unroll
            for (int e = 0; e < 2; ++e) { cs[0][e] = lf[0][e]; cs[1][e] = cs[0][e] + lf[1][e]; cs[2][e] = cs[1][e] + lf[2][e]; cs[3][e] = cs[2][e] + lf[3][e]; }
            *(LAS f32x2*)(TOT + w * 128 + 2 * lane) = (f32x2){cs[3][0], cs[3][1]};
            WG_BAR();
            float pre[2] = {0.f, 0.f}, tot[2] = {0.f, 0.f};
#pragma unroll
            for (int g = 0; g < 8; ++g) { const f32x2 tv = *(const LAS f32x2*)(TOT + g * 128 + 2 * lane); tot[0] += tv.x; tot[1] += tv.y; if (g < w) { pre[0] += tv.x; pre[1] += tv.y; } }
            float qd[4][2], kd[4][2], ke[4][2];
#pragma unroll
            for (int i = 0; i < 4; ++i)
#pragma unroll
                for (int e = 0; e < 2; ++e) { const float cum = pre[e] + cs[i][e], kk = 1.0f - __expf(lf[i][e]);
                    qd[i][e] = q[i][e] * __expf(cum); kd[i][e] = kk * __expf(-cum); ke[i][e] = kk * __expf(tot[e] - cum); }
            if (OUT) {
#pragma unroll
                for (int i = 0; i < 4; ++i) { *(LAS unsigned*)(lds + E_QD + (4 * w + i) * QP + 4 * lane) = pkbf(qd[i][0], qd[i][1]); *(LAS unsigned*)(lds + E_KD + (4 * w + i) * QP + 4 * lane) = pkbf(kd[i][0], kd[i][1]); }
            }
#pragma unroll
            for (int e = 0; e < 2; ++e) {
                u32x2 a; a.x = pkbf(ke[0][e], ke[1][e]); a.y = pkbf(ke[2][e], ke[3][e]); *(LAS u32x2*)(lds + E_KET + (2 * lane + e) * KP + posoff) = a;
                u32x2 b; b.x = pkbf(vv[0][e], vv[1][e]); b.y = pkbf(vv[2][e], vv[3][e]); *(LAS u32x2*)(lds + E_VT + (2 * lane + e) * KP + posoff) = b;
            }
            if (w == 0) { *(LAS f32x2*)(DEC + 2 * lane) = (f32x2){__expf(tot[0]), __expf(tot[1])}; slog0 += tot[0]; slog1 += tot[1]; }
            WG_BAR();
            if (OUT) {
#pragma unroll
                for (int tt = 0; tt < 2; ++tt) { const int tok = 32 * c + 16 * tt + fr; gpre[tt] = *(const u32x2*)(Gb + (size_t)(P.row0 + (tok < P.ntok ? tok : 0)) * 1024 + hh * 128 + vbase + 4 * fq); }
            }
        } else {
            const int g = P.head;
            int lnq = lane; asm volatile("" : "+v"(lnq));
            auto ldraw = [&](int col, int tokrel, float& x0, float& x1) {
                if (tokrel >= P.ntok) { x0 = 0.f; x1 = 0.f; }
                else if (tokrel + P.seq_t0 >= 0) { const unsigned a = *(const unsigned*)(XBC + (size_t)(P.row0 + tokrel) * 1536 + col); x0 = lo16(a); x1 = hi16(a); }
                else if (P.samp_b >= 0) { const f32x2 a = *(const f32x2*)(args.in[4] + (size_t)(P.samp_b * 3 + 3 + tokrel) * 1536 + col); x0 = a.x; x1 = a.y; }
                else { x0 = 0.f; x1 = 0.f; }
            };
            auto convact = [&](int col, float (&o)[4][2]) {
                float rr[7][2];
#pragma unroll
                for (int j = 0; j < 7; ++j) ldraw(col, tb - 3 + j, rr[j][0], rr[j][1]);
                const f32x2 cb = *(const f32x2*)(args.in[10] + col);
                f32x2 cw[4];
#pragma unroll
                for (int j = 0; j < 4; ++j) cw[j] = *(const f32x2*)(args.in[9] + j * 1536 + col);
#pragma unroll
                for (int i = 0; i < 4; ++i) {
                    float a0 = cb.x, a1 = cb.y;
#pragma unroll
                    for (int j = 0; j < 4; ++j) { a0 += cw[j].x * rr[i + j][0]; a1 += cw[j].y * rr[i + j][1]; }
                    const bool ok = (tb + i) < P.ntok;
                    o[i][0] = ok ? silu_f(a0) : 0.f; o[i][1] = ok ? silu_f(a1) : 0.f;
                }
            };
            auto convraw = [&](int col, const unsigned (&raw)[7], float (&o)[4][2]) {
                const f32x2 cb = *(const f32x2*)(args.in[10] + col);
                f32x2 cw[4];
#pragma unroll
                for (int j = 0; j < 4; ++j) cw[j] = *(const f32x2*)(args.in[9] + j * 1536 + col);
#pragma unroll
                for (int i = 0; i < 4; ++i) {
                    float a0 = cb.x, a1 = cb.y;
#pragma unroll
                    for (int j = 0; j < 4; ++j) { a0 += cw[j].x * lo16(raw[i + j]); a1 += cw[j].y * hi16(raw[i + j]); }
                    const bool ok = (tb + i) < P.ntok;
                    o[i][0] = ok ? silu_f(a0) : 0.f; o[i][1] = ok ? silu_f(a1) : 0.f;
                }
            };
            {
                const int l = lane & 31, tok = 32 * c + l;
                const float dt = usepf ? pdt : ((tok < P.ntok) ? DT[(size_t)(P.row0 + tok) * 16 + hh] : 0.f);
                float x = dt * A_h;
#pragma unroll
                for (int o = 1; o < 32; o <<= 1) { const float y = __shfl_up(x, o, 32); if (l >= o) x += y; }
                if (lane < 32) { CUM[hl * 32 + l] = x; DTV[hl * 32 + l] = dt; }
                const float th = __shfl(x, 31, 32);
                if (lane == 0) TOTH[hl] = th;
                slog0 += th;
            }
            {
                float ba[4][2];
                if (usepf) convraw(1024 + g * 128 + 2 * lnq, pB, ba); else convact(1024 + g * 128 + 2 * lnq, ba);
                u32x2 a0, a1; a0.x = pkbf(ba[0][0], ba[1][0]); a0.y = pkbf(ba[2][0], ba[3][0]); a1.x = pkbf(ba[0][1], ba[1][1]); a1.y = pkbf(ba[2][1], ba[3][1]);
                *(LAS u32x2*)(lds + E_KET + (2 * lane) * KP + posoff) = a0; *(LAS u32x2*)(lds + E_KET + (2 * lane + 1) * KP + posoff) = a1;
                if (OUT) {
#pragma unroll
                    for (int i = 0; i < 4; ++i) *(LAS unsigned*)(lds + E_KD + (4 * w + i) * QP + 4 * lane) = pkbf(ba[i][0], ba[i][1]);
                    float ca[4][2];
                    if (usepf) convraw(1280 + g * 128 + 2 * lnq, pC, ca); else convact(1280 + g * 128 + 2 * lnq, ca);
#pragma unroll
                    for (int i = 0; i < 4; ++i) *(LAS unsigned*)(lds + E_QD + (4 * w + i) * QP + 4 * lane) = pkbf(ca[i][0], ca[i][1]);
                }
            }
            WG_BAR();
#pragma unroll 1
            for (int jj = 0; jj < 2; ++jj) {
                const int cl = 2 * (lnq + 64 * jj), hc = cl >> 6;
                float xa[4][2];
                if (usepf) { if (jj == 0) convraw(g * 512 + 256 * P.half + cl, pX[0], xa); else convraw(g * 512 + 256 * P.half + cl, pX[1], xa); } else convact(g * 512 + 256 * P.half + cl, xa);
                const float th = TOTH[hc];
                float xd[4][2], xe[4][2];
#pragma unroll
                for (int i = 0; i < 4; ++i) { const float dtv = DTV[hc * 32 + 4 * w + i], te = __expf(th - CUM[hc * 32 + 4 * w + i]);
                    xd[i][0] = xa[i][0] * dtv; xd[i][1] = xa[i][1] * dtv; xe[i][0] = xd[i][0] * te; xe[i][1] = xd[i][1] * te; }
#pragma unroll
                for (int e = 0; e < 2; ++e) {
                    u32x2 b; b.x = pkbf(xe[0][e], xe[1][e]); b.y = pkbf(xe[2][e], xe[3][e]); *(LAS u32x2*)(lds + E_VTE + (cl + e) * KP + posoff) = b;
                    if (OUT) { u32x2 a; a.x = pkbf(xd[0][e], xd[1][e]); a.y = pkbf(xd[2][e], xd[3][e]); *(LAS u32x2*)(lds + E_VT + (cl + e) * KP + posoff) = a; }
                }
            }
            WG_BAR();
            if (c + 1 < P.nch) SS_PREFETCH(c + 1);
        }
        bf16x8 Pm[2];
        float ecum[2] = {1.f, 1.f};
        if (OUT) {
            f32x4 a00 = {0.f, 0.f, 0.f, 0.f}, a01 = a00, a11 = a00;
#pragma unroll
            for (int kk = 0; kk < 4; ++kk) {
                const bf16x8 k0 = *(const LAS bf16x8*)(lds + E_KD + fr * QP + 64 * kk + 16 * fq), k1 = *(const LAS bf16x8*)(lds + E_KD + (16 + fr) * QP + 64 * kk + 16 * fq);
                const bf16x8 q0 = *(const LAS bf16x8*)(lds + E_QD + fr * QP + 64 * kk + 16 * fq), q1 = *(const LAS bf16x8*)(lds + E_QD + (16 + fr) * QP + 64 * kk + 16 * fq);
                a00 = MFMA16(k0, q0, a00); a01 = MFMA16(k0, q1, a01); a11 = MFMA16(k1, q1, a11);
            }
            f32x4 z4 = {0.f, 0.f, 0.f, 0.f};
            if constexpr (MODE == 0) {
#pragma unroll
                for (int r = 0; r < 4; ++r) { const bool keep = (4 * fq + r) <= fr; a00[r] = keep ? a00[r] : 0.f; a11[r] = keep ? a11[r] : 0.f; }
            } else {
                const float ct0 = CUM[hl * 32 + fr], ct1 = CUM[hl * 32 + 16 + fr], dt0 = DTV[hl * 32 + fr], dt1 = DTV[hl * 32 + 16 + fr];
                const f32x4 cs0 = *(const LAS f32x4*)(CUM + hl * 32 + 4 * fq), cs1 = *(const LAS f32x4*)(CUM + hl * 32 + 16 + 4 * fq);
                const float dg0 = dt0 > 0.f ? Dsk / dt0 : 0.f, dg1 = dt1 > 0.f ? Dsk / dt1 : 0.f;
#pragma unroll
                for (int r = 0; r < 4; ++r) { const int s = 4 * fq + r; const bool keep = s <= fr, dg = s == fr;
                    const float v00 = a00[r] * __expf(fminf(ct0 - cs0[r], 0.f)), v01 = a01[r] * __expf(fminf(ct1 - cs0[r], 0.f)), v11 = a11[r] * __expf(fminf(ct1 - cs1[r], 0.f));
                    a00[r] = (keep ? v00 : 0.f) + (dg ? dg0 : 0.f); a01[r] = v01; a11[r] = (keep ? v11 : 0.f) + (dg ? dg1 : 0.f); }
                ecum[0] = __expf(ct0); ecum[1] = __expf(ct1);
            }
            Pm[0] = pack8(a00, z4); Pm[1] = pack8(a01, a11);
        }
        f32x4 o[NV][2];
#pragma unroll
        for (int vt = 0; vt < NV; ++vt) {
            asm volatile("" ::: "memory");
            const bf16x8 vtf = *(const LAS bf16x8*)(lds + E_VT + (vbase + 16 * vt + fr) * KP + 16 * fq);
            if (OUT) {
                f32x4 o0 = {0.f, 0.f, 0.f, 0.f}, o1 = o0;
#pragma unroll
                for (int j = 0; j < 4; ++j) {
                    const bf16x8 sb = pack8(S[2 * j][vt], S[2 * j + 1][vt]);
                    const u32x2 qa = *(const LAS u32x2*)(lds + E_QD + fr * QP + 64 * j + 8 * fq), qb = *(const LAS u32x2*)(lds + E_QD + fr * QP + 64 * j + 32 + 8 * fq);
                    const u32x2 qc = *(const LAS u32x2*)(lds + E_QD + (16 + fr) * QP + 64 * j + 8 * fq), qe = *(const LAS u32x2*)(lds + E_QD + (16 + fr) * QP + 64 * j + 32 + 8 * fq);
                    u32x4 t0; t0.x = qa.x; t0.y = qa.y; t0.z = qb.x; t0.w = qb.y; u32x4 t1; t1.x = qc.x; t1.y = qc.y; t1.z = qe.x; t1.w = qe.y;
                    o0 = MFMA16(sb, __builtin_bit_cast(bf16x8, t0), o0); o1 = MFMA16(sb, __builtin_bit_cast(bf16x8, t1), o1);
                }
                if constexpr (MODE == 1) { o0 = o0 * ecum[0]; o1 = o1 * ecum[1]; }
                o0 = MFMA16(vtf, Pm[0], o0); o1 = MFMA16(vtf, Pm[1], o1);
                o[vt][0] = o0; o[vt][1] = o1;
            }
            bf16x8 vte = vtf;
            if constexpr (MODE == 1) vte = *(const LAS bf16x8*)(lds + E_VTE + (vbase + 16 * vt + fr) * KP + 16 * fq);
            float dsc = 1.f;
            if constexpr (MODE == 1) dsc = __expf(TOTH[hl]);
#pragma unroll
            for (int kt = 0; kt < 8; ++kt) {
                const bf16x8 kf = *(const LAS bf16x8*)(lds + E_KET + (16 * kt + fr) * KP + 16 * fq);
                f32x4 sc;
                if constexpr (MODE == 0) sc = S[kt][vt] * *(const LAS f32x4*)(DEC + 16 * kt + 4 * fq); else sc = S[kt][vt] * dsc;
                S[kt][vt] = MFMA16(kf, vte, sc);
            }
        }
        if (OUT) {
            if constexpr (MODE == 0) {
                f32x4 gz[2]; bool val[2]; size_t rowt[2];
#pragma unroll
                for (int tt = 0; tt < 2; ++tt) {
                    const int tok = 32 * c + 16 * tt + fr; val[tt] = tok < P.ntok; rowt[tt] = (size_t)(P.row0 + (val[tt] ? tok : 0));
                    const u32x2 gg = gpre[tt];
                    gz[tt] = (f32x4){lo16(gg.x), hi16(gg.x), lo16(gg.y), hi16(gg.y)};
                    const f32x4 y = o[0][tt]; float ss = (y[0] * y[0] + y[1] * y[1]) + (y[2] * y[2] + y[3] * y[3]);
                    ss += __shfl_xor(ss, 16); ss += __shfl_xor(ss, 32);
                    if (fq == 0) RED[(16 * tt + fr) * 8 + w] = ss;
                }
                WG_BAR();
                const f32x4 gn = *(const f32x4*)(args.in[8] + hh * 128 + vbase + 4 * fq);
#pragma unroll
                for (int tt = 0; tt < 2; ++tt) {
                    const f32x4 r0 = *(const LAS f32x4*)(RED + (16 * tt + fr) * 8), r1 = *(const LAS f32x4*)(RED + (16 * tt + fr) * 8 + 4);
                    const float tot = ((r0[0] + r0[1]) + (r0[2] + r0[3])) + ((r1[0] + r1[1]) + (r1[2] + r1[3]));
                    const float rstd = __builtin_amdgcn_rsqf(tot * (1.0f / 128.0f) + EPS);
                    const f32x4 res = o[0][tt] * rstd * gn * gz[tt];
                    u32x2 wv; wv.x = pkbf(res[0], res[1]); wv.y = pkbf(res[2], res[3]);
                    if (val[tt]) *(u32x2*)(QZ + rowt[tt] * 2048 + hh * 128 + vbase + 4 * fq) = wv;
                }
            } else {
                float* SSQ = (float*)(ws + WS_SSQ);
#pragma unroll
                for (int tt = 0; tt < 2; ++tt) {
                    const int tok = 32 * c + 16 * tt + fr; const bool val = tok < P.ntok; const size_t row = (size_t)(P.row0 + (val ? tok : 0));
                    float ss = 0.f;
#pragma unroll
                    for (int vt = 0; vt < NV; ++vt) {
                        bf16* zp = QZ + row * 2048 + 1024 + P.head * 512 + 256 * P.half + vbase + 16 * vt + 4 * fq;
                        const u32x2 gg = *(const u32x2*)zp;
                        const f32x4 y = o[vt][tt] * (f32x4){lo16(gg.x), hi16(gg.x), lo16(gg.y), hi16(gg.y)};
                        u32x2 wv; wv.x = pkbf(y[0], y[1]); wv.y = pkbf(y[2], y[3]);
                        const f32x4 yr = {lo16(wv.x), hi16(wv.x), lo16(wv.y), hi16(wv.y)};
                        ss += (yr[0] * yr[0] + yr[1] * yr[1]) + (yr[2] * yr[2] + yr[3] * yr[3]);
                        if (val) *(u32x2*)zp = wv;
                    }
                    ss += __shfl_xor(ss, 16); ss += __shfl_xor(ss, 32);
                    if (fq == 0 && val) unsafeAtomicAdd(SSQ + row * 2 + P.head, ss);
                }
                WG_BAR();
            }
        } else {
            WG_BAR();
        }
    }
    if (P.out_lay == 2) {
        f32x4* sp = (f32x4*)P.Sout;
#pragma unroll
        for (int kt = 0; kt < 8; ++kt)
#pragma unroll
            for (int vt = 0; vt < NV; ++vt) sp[((w * 8 + kt) * NV + vt) * 64 + lane] = S[kt][vt];
    } else if (P.out_lay == 1) {
        if constexpr (MODE == 0) {
#pragma unroll
            for (int kt = 0; kt < 8; ++kt)
#pragma unroll
                for (int r = 0; r < 4; ++r) P.Sout[(size_t)(16 * kt + 4 * fq + r) * 128 + 16 * w + fr] = S[kt][0][r];
        } else {
            float* sb = P.Sout + (size_t)hl * 8192 + (size_t)(32 * (w & 1)) * 128;
#pragma unroll
            for (int kt = 0; kt < 8; ++kt)
#pragma unroll
                for (int vt = 0; vt < NV; ++vt) *(f32x4*)(sb + (size_t)(16 * vt + fr) * 128 + 16 * kt + 4 * fq) = S[kt][vt];
        }
    }
    if (P.Dout) {
        if constexpr (MODE == 0) { if (w == 0) *(f32x2*)(P.Dout + 2 * lane) = (f32x2){__expf(slog0), __expf(slog1)}; }
        else { if (lane == 0 && (w & 1) == 0) P.Dout[hl] = __expf(slog0); }
    }
    (void)slog1;
}
#ifndef ENG_H
#define ENG_H 1
#endif
#ifndef ENG_S
#define ENG_S 1
#endif

__device__ __forceinline__ float* hseg_slot(unsigned char* ws, int bh, int s) { return (float*)(ws + WS_HSEG) + ((size_t)bh * 3 + s) * 16384; }
__device__ __forceinline__ float* sseg_slot(unsigned char* ws, int bg, int s) { return (float*)(ws + WS_SSEG) + ((size_t)bg * 7 + s) * 32768; }

__device__ __forceinline__ void phase_2a(LAS unsigned char* lds, const Args& args, int lane, int w) {
    unsigned char* ws = args.ws;
    for (int i = blockIdx.x; i < 256; i += gridDim.x) {
        if (ENG_H && i < 192) {
            const int bh = i / 3, seg = i % 3;
            GlaP p; p.row0 = (bh >> 3) * 2048 + seg * 512; p.ntok = 512; p.nch = 16; p.seq_t0 = seg * 512; p.head = bh & 7; p.half = 0; p.samp_b = -1;
            p.Sinit = nullptr; p.init_lay = 0; p.Sout = hseg_slot(ws, bh, seg); p.out_lay = 2; p.Dout = (float*)(ws + WS_HD) + (bh * 3 + seg) * 128;
            gla_unit<0, false>(lds, p, args, lane, w);
        }
        const int j0 = (i >= 192) ? 2 * (i - 192) : (i < 96 ? 128 + i : 0), nj = !ENG_S ? 0 : (i >= 192) ? 2 : (i < 96 ? 1 : 0);
        for (int j = j0; j < j0 + nj; ++j) {
            const int u = j / 7, seg = j % 7, b = u >> 2, g = (u >> 1) & 1;
            GlaP p; p.row0 = b * 2048 + seg * 256; p.ntok = 256; p.nch = 8; p.seq_t0 = seg * 256; p.head = g; p.half = u & 1; p.samp_b = -1;
            p.Sinit = nullptr; p.init_lay = 0; p.Sout = sseg_slot(ws, u, seg); p.out_lay = 2; p.Dout = (float*)(ws + WS_SD) + (u * 7 + seg) * 32;
            gla_unit<1, false>(lds, p, args, lane, w);
        }
    }
}
__device__ __forceinline__ void phase_2b(const Args& args, int tid) {
    unsigned char* ws = args.ws;
    const int gt = blockIdx.x * 512 + tid, NGT = gridDim.x * 512;
    for (int it = gt; it < 64 * 4096; it += NGT) {
        const int bh = it >> 12, e4 = it & 4095, kt = (e4 >> 6) & 7, fq = (e4 & 63) >> 4, k = 16 * kt + 4 * fq;
        f32x4 s = ((const f32x4*)hseg_slot(ws, bh, 0))[e4];
#pragma unroll
        for (int sl = 1; sl < 3; ++sl) { const f32x4 d = *(const f32x4*)((const float*)(ws + WS_HD) + (bh * 3 + sl) * 128 + k); f32x4* p = (f32x4*)hseg_slot(ws, bh, sl) + e4; s = d * s + *p; *p = s; }
    }
    for (int it = gt; it < 32 * 8192; it += NGT) {
        const int bg = it >> 13, e4 = it & 8191, wv = e4 >> 10;
        f32x4 s = ((const f32x4*)sseg_slot(ws, bg, 0))[e4];
#pragma unroll
        for (int sl = 1; sl < 7; ++sl) { const float d = ((const float*)(ws + WS_SD))[(bg * 7 + sl) * 32 + (wv >> 1)]; f32x4* p = (f32x4*)sseg_slot(ws, bg, sl) + e4; s = s * d + *p; *p = s; }
    }
}
__device__ __forceinline__ void phase_2c(LAS unsigned char* lds, const Args& args, int lane, int w) {
    unsigned char* ws = args.ws;
    for (int i = blockIdx.x; i < 256; i += gridDim.x) {
        for (int n0 = 0; n0 < (ENG_S ? 3 : 0); ++n0) {
            const int n = (i & 1) ? (n0 + 1) % 3 : n0;
            GlaP p; p.Dout = nullptr;
            if (n == 0) { const int u = i >> 3, seg = i & 7, b = u >> 2, g = (u >> 1) & 1;
                p.row0 = b * 2048 + seg * 256; p.ntok = 256; p.nch = 8; p.seq_t0 = seg * 256; p.head = g; p.half = u & 1; p.samp_b = -1;
                p.Sinit = seg ? sseg_slot(ws, u, seg - 1) : nullptr; p.init_lay = seg ? 2 : 0;
                p.Sout = (seg == 7) ? args.out + O_SSP + (size_t)(b * 16 + 8 * g + 4 * (u & 1)) * 8192 : nullptr; p.out_lay = (seg == 7) ? 1 : 0;
            } else { const int u = 2 * i + n - 1, b = u >> 2, g = (u >> 1) & 1;
                p.row0 = MP + 8 * b; p.ntok = 8; p.nch = 1; p.seq_t0 = 0; p.head = g; p.half = u & 1; p.samp_b = b;
                p.Sinit = args.in[3] + (size_t)(b * 16 + 8 * g + 4 * (u & 1)) * 8192; p.init_lay = 1; p.Sout = args.out + O_SSS + (size_t)(b * 16 + 8 * g + 4 * (u & 1)) * 8192; p.out_lay = 1; }
            gla_unit<1, true>(lds, p, args, lane, w);
        }
        for (int n0 = 0; n0 < (ENG_H ? 5 : 0); ++n0) {
            const int n = (i & 1) ? (n0 + 1) % 5 : n0;
            GlaP p; p.Dout = nullptr; p.half = 0;
            if (n == 0) { const int bh = i >> 2, seg = i & 3;
                p.row0 = (bh >> 3) * 2048 + seg * 512; p.ntok = 512; p.nch = 16; p.seq_t0 = seg * 512; p.head = bh & 7; p.samp_b = -1;
                p.Sinit = seg ? hseg_slot(ws, bh, seg - 1) : nullptr; p.init_lay = seg ? 2 : 0;
                p.Sout = (seg == 3) ? args.out + O_HGP + (size_t)bh * 16384 : nullptr; p.out_lay = (seg == 3) ? 1 : 0;
            } else { const int u = 4 * i + n - 1, b = u >> 3;
                p.row0 = MP + 8 * b; p.ntok = 8; p.nch = 1; p.seq_t0 = 0; p.head = u & 7; p.samp_b = b;
                p.Sinit = args.in[2] + (size_t)u * 16384; p.init_lay = 1; p.Sout = args.out + O_HGS + (size_t)u * 16384; p.out_lay = 1; }
            gla_unit<0, true>(lds, p, args, lane, w);
        }
    }
}
__device__ __forceinline__ void phase_2d(const Args& args, int tid) {
    unsigned char* ws = args.ws; bf16* QZ = (bf16*)(ws + WS_QZ); const float* SSQ = (const float*)(ws + WS_SSQ);
    for (int it = blockIdx.x * 512 + tid; it < M * 128; it += gridDim.x * 512) {
        const int row = it >> 7, c8 = (it & 127) * 8, g = c8 >> 9;
        const float rs = __builtin_amdgcn_rsqf(SSQ[row * 2 + g] * (1.0f / 512.0f) + EPS);
        u32x4* p = (u32x4*)(QZ + (size_t)row * 2048 + 1024 + c8); const u32x4 v = *p;
        const f32x4 g0 = *(const f32x4*)(args.in[14] + c8), g1 = *(const f32x4*)(args.in[14] + c8 + 4);
        u32x4 o; o.x = pkbf(lo16(v.x) * rs * g0[0], hi16(v.x) * rs * g0[1]); o.y = pkbf(lo16(v.y) * rs * g0[2], hi16(v.y) * rs * g0[3]);
        o.z = pkbf(lo16(v.z) * rs * g1[0], hi16(v.z) * rs * g1[1]); o.w = pkbf(lo16(v.w) * rs * g1[2], hi16(v.w) * rs * g1[3]);
        *p = o;
    }
}
__global__ void __launch_bounds__(NWAVES * 64, 2) mega(Args args) {
    extern __shared__ __attribute__((aligned(16))) unsigned char lds_raw[];
    LAS unsigned char* lds = (LAS unsigned char*)lds_raw;
    const int tid = threadIdx.x, lane = tid & 63, wave = __builtin_amdgcn_readfirstlane(tid >> 6);
    const int lo = args.ph_lo, hi = args.ph_hi, G = gridDim.x;
    unsigned char* ws = args.ws;
#define IN(k) (lo <= (k) && (k) < hi)
    volatile LAS unsigned* bst = (volatile LAS unsigned*)(lds + LDS_BYTES - 64);
    if (tid < 2) bst[tid] = 0u;
    __syncthreads();
    XcdBarrier bar = xcd_barrier_post((unsigned*)(ws + WS_BAR), bst);
#define SEAM(k) do { if (IN(k) && IN((k) + 1)) { xcd_barrier(bar); } } while (0)
    if (IN(0)) { p0_prologue(args, lds, tid, lane, wave); __syncthreads(); }
    SEAM(0);
    if (IN(1)) {
        pg8::Gemm g{(const bf16*)(ws + WS_XN), (const bf16*)(ws + WS_WIN), M, NIN, D, D}; pg8::StaticOrder S; S.init(M, NIN, G, (int)blockIdx.x);
        pg8::EpiIn E{(bf16*)(ws + WS_QZ), (bf16*)(ws + WS_F), (bf16*)(args.out) + (size_t)M * 1024, (bf16*)(args.out), (bf16*)(ws + WS_XBC), (const float*)(ws + WS_LB), args.out + O_CVP, args.out + O_CVS};
        pg8::gemm_phase<pg8::EpiIn, pg8::StaticOrder, true, true>(lds, g, S, E);
    }
    SEAM(1);
    if (IN(2)) { phase_2a(lds, args, lane, wave);
        if (!ENG_S) { for (size_t idx = (size_t)blockIdx.x * 512 + tid; idx < (size_t)M * 1536; idx += (size_t)G * 512) conv_act_elem((const bf16*)(ws + WS_XBC), args.in[4], args.in[9], args.in[10], (bf16*)(ws + 204 * MiB), idx); } }
    SEAM(2);
    if (IN(3)) { phase_2b(args, tid); }
    SEAM(3);
    if (IN(4)) { phase_2c(lds, args, lane, wave);
        LAS float* red = (LAS float*)lds;
        if (!ENG_H) { __syncthreads();
            for (int grp = blockIdx.x; grp < 16 + 256; grp += G)
                simple_hgrn(red + 2 * (tid >> 7), grp * 4 + (tid >> 7), tid & 127, (bf16*)(ws + WS_QZ), (const unsigned short*)(ws + WS_F), (const bf16*)(args.out) + (size_t)M * 1024, (const bf16*)(args.out), args.in[2], args.in[8], args.out + O_HGP, args.out + O_HGS);
            __syncthreads(); }
        if (!ENG_S) { __syncthreads();
            for (int u = blockIdx.x; u < 16 + 256; u += G)
                simple_ssd(red + 16, u, (bf16*)(ws + WS_QZ), (const bf16*)(ws + 204 * MiB), (const float*)(ws + WS_DT), args.in[3], args.in[12], args.in[13], args.in[14], args.out + O_SSP, args.out + O_SSS);
            __syncthreads(); }
    }
    SEAM(4);
    if (IN(5) && ENG_S) { phase_2d(args, tid); }
    SEAM(5);
    if (IN(6)) {
        late_weight_copies(args, lds, lane, wave); __syncthreads();
        {
            pg8::Gemm g{(const bf16*)(ws + WS_QZ), (const bf16*)(ws + WS_WOUT), M, D, DMIX / 4, DMIX}; pg8::SplitOrder S{G, (int)blockIdx.x};
            pg8::EpiDownSplit E{(float*)(ws + WS_PART)};
            pg8::gemm_phase<pg8::EpiDownSplit, pg8::SplitOrder, true, true>(lds, g, S, E);
        }
        pg8::Gemm g{(const bf16*)(ws + WS_QZ), (const bf16*)(ws + WS_WOUT), MP, D, DMIX, DMIX}; pg8::StaticOrder S; S.init(MP, D, G, (int)blockIdx.x);
        pg8::EpiOut E{args.in[0], args.in[1], args.out + O_Y, (bf16*)(ws + WS_XG), args.in[16], (float*)(ws + WS_RSS1)};
        pg8::gemm_phase<pg8::EpiOut, pg8::StaticOrder, true, true>(lds, g, S, E);
        xcd_barrier(bar);
        p3_finish_samples(args, lane, wave);
    }
    SEAM(6);
    if (IN(7)) {
        pg8::Gemm g{(const bf16*)(ws + WS_XG), (const bf16*)(ws + WS_WUP), M, FF, D, D}; pg8::StaticOrder S; S.init(M, FF, G, (int)blockIdx.x);
        pg8::EpiUp E{(bf16*)(ws + WS_U), (const float*)(ws + WS_RSS1)};
        pg8::gemm_phase<pg8::EpiUp, pg8::StaticOrder, true, true>(lds, g, S, E);
    }
    SEAM(7);
    if (IN(8)) {
        {
            pg8::Gemm g{(const bf16*)(ws + WS_U), (const bf16*)(ws + WS_WDN), M, D, FF / 4, FF}; pg8::SplitOrder S{G, (int)blockIdx.x};
            pg8::EpiDownSplit E{(float*)(ws + WS_PART)};
            pg8::gemm_phase<pg8::EpiDownSplit, pg8::SplitOrder, true, true>(lds, g, S, E);
        }
        pg8::Gemm g{(const bf16*)(ws + WS_U), (const bf16*)(ws + WS_WDN), MP, D, FF, FF}; pg8::StaticOrder S; S.init(MP, D, G, (int)blockIdx.x);
        pg8::EpiDown E{args.out + O_Y};
        pg8::gemm_phase<pg8::EpiDown, pg8::StaticOrder, true, true>(lds, g, S, E);
    }
    SEAM(8);
    if (IN(9)) p6_final(args, lane, wave);
#undef IN
#undef SEAM
}
extern "C" void kernel_launch(void* const* d_in, const int* in_sizes, int n_in, void* d_out, int out_size, void* d_ws, size_t ws_size, hipStream_t stream) {
    static int grid = 0;
    if (grid == 0) {
        int dev = 0, cus = 0, per_cu = 0;
        (void)hipGetDevice(&dev); (void)hipDeviceGetAttribute(&cus, hipDeviceAttributeMultiprocessorCount, dev);
        if (hipFuncSetAttribute((const void*)mega, hipFuncAttributeMaxDynamicSharedMemorySize, LDS_BYTES) != hipSuccess) { fprintf(stderr, "hipFuncSetAttribute failed\n"); grid = -1; return; }
        if (n_in != 20 || out_size != (int)O_END || ws_size < WS_END) { fprintf(stderr, "kernel_launch: unexpected sizes n_in %d out %d ws %zu\n", n_in, out_size, ws_size); grid = -1; return; }
        if (hipOccupancyMaxActiveBlocksPerMultiprocessor(&per_cu, (const void*)mega, 512, LDS_BYTES) != hipSuccess || per_cu < 1) { fprintf(stderr, "occupancy query failed (%d)\n", per_cu); grid = -1; return; }
        grid = (cus > 0 ? cus : 256) * 1;
    }
    if (grid < 0) return;
    Args a{};
    for (int i = 0; i < 20; ++i) a.in[i] = (const float*)d_in[i];
    a.out = (float*)d_out; a.ws = (unsigned char*)d_ws; a.ph_lo = 0; a.ph_hi = 10;
    if (hipMemsetAsync((char*)d_ws + WS_BAR, 0, 16384, stream) != hipSuccess) { fprintf(stderr, "memset failed\n"); return; }
    void* kargs[] = {&a};
    hipError_t e = hipLaunchCooperativeKernel((const void*)mega, dim3(grid), dim3(512), kargs, LDS_BYTES, stream);
    if (e != hipSuccess) fprintf(stderr, "cooperative launch failed: %s (grid %d)\n", hipGetErrorString(e), grid);
}
```
